# Optimizing an MI355X kernel written in HIP

```python
import math
import jax, jax.numpy as jnp
from jax import lax
import numpy as np

D_MODEL = 1024
BATCH = 8
SEQ = 8192
DEPTH = 1

GRID_W = 64
CTX_LEN = 256
MIX_WIDTH = D_MODEL
HY_WIDTH = MIX_WIDTH // 2
RET_WIDTH = MIX_WIDTH - HY_WIDTH
RET_HEADS = 8
RET_HEAD_DIM = RET_WIDTH // RET_HEADS
RET_CHUNK = 128
HY_ORDER = 2
HY_PROJ = (HY_ORDER + 1) * HY_WIDTH
IN_COLS = HY_PROJ + 4 * RET_WIDTH
SHORT_CONV_W = 3
HY_BANDS = 16
HY_EMB = 1 + 2 * HY_BANDS
HY_FILT_HID = 64
HY_DECAY_TARGET = 1e-2
HY_FAST_PCT = 0.3
HY_SLOW_PCT = 1.5
D_FF = 4 * D_MODEL
ROPE_BASE = 10000.0
ROPE_PAIRS_AXIS = RET_HEAD_DIM // 4
NORM_EPS = 1e-6

kernel_name = "hymba_hyena_retnet_dit_block"

F32 = jnp.float32


def _rmsnorm(x, g):
    xf = x.astype(F32)
    y = xf * lax.rsqrt(jnp.mean(jnp.square(xf), axis=-1, keepdims=True) + NORM_EPS)
    return (y * g.astype(F32)).astype(x.dtype)


def _modulate(h, shift, scale):
    return h * (1.0 + scale) + shift


def _rope_2d(L):
    rows = L // GRID_W
    r, col = jnp.meshgrid(jnp.arange(rows, dtype=F32), jnp.arange(GRID_W, dtype=F32), indexing="ij")
    inv = ROPE_BASE ** (-jnp.arange(ROPE_PAIRS_AXIS, dtype=F32) / ROPE_PAIRS_AXIS)
    ang = jnp.concatenate([r.reshape(-1, 1) * inv, col.reshape(-1, 1) * inv], axis=-1)
    return jnp.cos(ang), jnp.sin(ang)


def _apply_rope(t, rope):
    cos, sin = rope
    t2 = t.reshape(t.shape[:-1] + (RET_HEAD_DIM // 2, 2))
    a, b = t2[..., 0], t2[..., 1]
    cs, sn = cos[None, :, None, :], sin[None, :, None, :]
    return jnp.stack([a * cs - b * sn, a * sn + b * cs], axis=-1).reshape(t.shape)


def _short_conv(u, w, b):
    up = jnp.pad(u, ((0, 0), (1, 1), (0, 0)))
    return up[:, :-2] * w[0] + up[:, 1:-1] * w[1] + up[:, 2:] * w[2] + b


def _hyena_filters(L, w1, b1, fr1, w2, b2, fr2, w3):
    t = jnp.linspace(0.0, 1.0, L, dtype=F32)[:, None]
    w = (2.0 * math.pi / L) * jnp.arange(L, dtype=F32)[:, None]
    bands = jnp.linspace(1e-4, HY_BANDS - 1, HY_BANDS, dtype=F32)[None, :]
    z = jnp.concatenate([t, jnp.cos(bands * w), -jnp.sin(bands * w)], axis=-1)
    h = jnp.sin(fr1.astype(F32) * (z @ w1.astype(F32) + b1.astype(F32)))
    h = jnp.sin(fr2.astype(F32) * (h @ w2.astype(F32) + b2.astype(F32)))
    h = (h @ w3.astype(F32)).reshape(L, 2, HY_WIDTH)
    deltas = jnp.abs(jnp.linspace(math.log(HY_DECAY_TARGET) / HY_SLOW_PCT,
                                  math.log(HY_DECAY_TARGET) / HY_FAST_PCT, HY_WIDTH, dtype=F32))
    h = h * jnp.exp(-t * deltas)[:, None, :]
    return h / (jnp.sum(jnp.abs(h), axis=(0, 1), keepdims=True) + 1e-6)


def _bidir_long_conv(v, h, bias):
    L = v.shape[1]
    k = jnp.concatenate([h[:, 0], jnp.zeros((1, HY_WIDTH), F32), h[:0:-1, 1]], axis=0)
    vf = jnp.fft.rfft(v.astype(F32), n=2 * L, axis=1)
    kf = jnp.fft.rfft(k, n=2 * L, axis=0)
    y = jnp.fft.irfft(vf * kf[None], n=2 * L, axis=1)[:, :L]
    return (y + v.astype(F32) * bias.astype(F32)).astype(v.dtype)


def _ret_heads(t):
    B, L, _ = t.shape
    return t.reshape(B, L, RET_HEADS, RET_HEAD_DIM)


def _ret_kv(u):
    _, k, v, _ = jnp.split(u[..., HY_PROJ:], 4, axis=-1)
    k = _ret_heads(k).astype(F32) * (RET_HEAD_DIM ** -0.5)
    v = _ret_heads(v).astype(F32)
    return k.transpose(0, 2, 1, 3), v.transpose(0, 2, 1, 3)


def _ret_final_state(k, v, log_gamma):
    Lc = k.shape[2]
    w = jnp.exp(log_gamma[:, None] * (Lc - 1 - jnp.arange(Lc, dtype=F32))[None, :])
    return jnp.einsum("bhmd,bhme->bhde", k * w[None, :, :, None], v)


def _retention_chunkwise(q, k, v, log_gamma, s0):
    B, H, L, dk = q.shape
    dv = v.shape[-1]
    C = RET_CHUNK
    N = L // C
    qc = q.reshape(B, H, N, C, dk)
    kc = k.reshape(B, H, N, C, dk)
    vc = v.reshape(B, H, N, C, dv)
    idx = jnp.arange(C, dtype=F32)
    lg = log_gamma[:, None]
    diff = idx[:, None] - idx[None, :]
    dmask = jnp.where(diff >= 0, jnp.exp(lg[:, :, None] * jnp.maximum(diff, 0.0)[None]), 0.0)
    scores = jnp.einsum("bhncd,bhnmd->bhncm", qc, kc) * dmask[None, :, None]
    out_inner = jnp.einsum("bhncm,bhnme->bhnce", scores, vc)
    w_k = jnp.exp(lg * (C - 1 - idx)[None, :])
    t = jnp.einsum("bhnmd,bhnme->bhnde", kc * w_k[None, :, None, :, None], vc)
    decay_chunk = jnp.exp(log_gamma * C)[None, :, None, None]

    def step(s, t_n):
        return decay_chunk * s + t_n, s

    _, s_prev = lax.scan(step, s0, jnp.moveaxis(t, 2, 0))
    s_prev = jnp.moveaxis(s_prev, 0, 2)
    w_q = jnp.exp(lg * (idx + 1.0)[None, :])
    out_cross = jnp.einsum("bhncd,bhnde->bhnce", qc * w_q[None, :, None, :, None], s_prev)
    return (out_inner + out_cross).reshape(B, H, L, dv)


def _token_mixers(u, rope, s0_f, s0_b, conv_w, conv_b, f_w1, f_b1, f_fr1, f_w2, f_b2, f_fr2, f_w3,
                  hy_bias, log_gamma, gn_g):
    B, L, _ = u.shape
    uh = _short_conv(u[..., :HY_PROJ], conv_w, conv_b)
    x0, x1, v = jnp.split(uh, 3, axis=-1)
    h = _hyena_filters(L, f_w1, f_b1, f_fr1, f_w2, f_b2, f_fr2, f_w3)
    y_hy = _bidir_long_conv(v * x1, h, hy_bias) * x0
    q, k, vr, g = jnp.split(u[..., HY_PROJ:], 4, axis=-1)
    q = _ret_heads(q)
    k = _ret_heads(k) * (RET_HEAD_DIM ** -0.5)
    if rope is not None:
        q = _apply_rope(q, rope)
        k = _apply_rope(k, rope)
    q = q.astype(F32).transpose(0, 2, 1, 3)
    k = k.astype(F32).transpose(0, 2, 1, 3)
    vr = _ret_heads(vr).astype(F32).transpose(0, 2, 1, 3)
    o_f = _retention_chunkwise(q, k, vr, log_gamma[0], s0_f)
    o_b = jnp.flip(_retention_chunkwise(jnp.flip(q, 2), jnp.flip(k, 2), jnp.flip(vr, 2), log_gamma[1], s0_b), 2)
    o = (o_f + o_b).transpose(0, 2, 1, 3)
    mu = jnp.mean(o, axis=-1, keepdims=True)
    var = jnp.mean(jnp.square(o - mu), axis=-1, keepdims=True)
    o = ((o - mu) * lax.rsqrt(var + NORM_EPS)).reshape(B, L, RET_WIDTH) * gn_g.astype(F32)
    y_ret = (o * jax.nn.silu(g.astype(F32))).astype(u.dtype)
    return jnp.concatenate([y_hy, y_ret], axis=-1)


def _sq_relu_mlp(h, w1, w2):
    return jnp.square(jax.nn.relu(h @ w1)) @ w2


def setup_inputs(seed: int = 0) -> dict:
    key = jax.random.key(seed)
    ks = jax.random.split(key, 28)

    def nrm(k, shape, scale):
        return scale * jax.random.normal(k, shape, F32)

    g0 = 1.0 - 2.0 ** (-5.0 - np.arange(RET_HEADS))
    logit0 = jnp.asarray(np.log(g0) - np.log1p(-g0), dtype=F32)
    return {
        "x": nrm(ks[0], (BATCH, SEQ, D_MODEL), 1.0),
        "c": nrm(ks[1], (BATCH, D_MODEL), 1.0),
        "ctx": nrm(ks[2], (BATCH, CTX_LEN, D_MODEL), 1.0),
        "c_ctx": nrm(ks[3], (D_MODEL,), 1.0),
        "w_ada": nrm(ks[4], (DEPTH, D_MODEL, 6 * D_MODEL), 0.2 * D_MODEL ** -0.5),
        "b_ada": nrm(ks[5], (DEPTH, 6 * D_MODEL), 0.02),
        "norm1_g": 1.0 + nrm(ks[6], (DEPTH, D_MODEL), 0.02),
        "w_in": nrm(ks[7], (DEPTH, D_MODEL, IN_COLS), D_MODEL ** -0.5),
        "hy_conv_w": nrm(ks[8], (DEPTH, SHORT_CONV_W, HY_PROJ), SHORT_CONV_W ** -0.5),
        "hy_conv_b": nrm(ks[9], (DEPTH, HY_PROJ), 0.02),
        "hy_f_w1": nrm(ks[10], (DEPTH, HY_EMB, HY_FILT_HID), HY_EMB ** -0.5),
        "hy_f_b1": nrm(ks[11], (DEPTH, HY_FILT_HID), 0.02),
        "hy_f_freq1": 1.0 + nrm(ks[12], (DEPTH, HY_FILT_HID), 0.02),
        "hy_f_w2": nrm(ks[13], (DEPTH, HY_FILT_HID, HY_FILT_HID), HY_FILT_HID ** -0.5),
        "hy_f_b2": nrm(ks[14], (DEPTH, HY_FILT_HID), 0.02),
        "hy_f_freq2": 1.0 + nrm(ks[15], (DEPTH, HY_FILT_HID), 0.02),
        "hy_f_w3": nrm(ks[16], (DEPTH, HY_FILT_HID, 2 * HY_WIDTH), HY_FILT_HID ** -0.5),
        "hy_bias": nrm(ks[17], (DEPTH, HY_WIDTH), 0.5),
        "ret_decay_logit": logit0[None, None, :] + nrm(ks[18], (DEPTH, 2, RET_HEADS), 0.1),
        "ret_gn_g": 1.0 + nrm(ks[19], (DEPTH, RET_WIDTH), 0.02),
        "w_out": nrm(ks[20], (DEPTH, MIX_WIDTH, D_MODEL), MIX_WIDTH ** -0.5),
        "norm2_g": 1.0 + nrm(ks[21], (DEPTH, D_MODEL), 0.02),
        "w_mlp1": nrm(ks[22], (DEPTH, D_MODEL, D_FF), D_MODEL ** -0.5),
        "w_mlp2": nrm(ks[23], (DEPTH, D_FF, D_MODEL), D_FF ** -0.5),
        "norm_f_g": 1.0 + nrm(ks[24], (D_MODEL,), 0.02),
    }


def reference(x, c, ctx, c_ctx, w_ada, b_ada, norm1_g, w_in, hy_conv_w, hy_conv_b, hy_f_w1, hy_f_b1,
              hy_f_freq1, hy_f_w2, hy_f_b2, hy_f_freq2, hy_f_w3, hy_bias, ret_decay_logit, ret_gn_g,
              w_out, norm2_g, w_mlp1, w_mlp2, norm_f_g):
    L = x.shape[1]
    rope = _rope_2d(L)
    for l in range(DEPTH):
        mx = jnp.split(jax.nn.silu(c) @ w_ada[l] + b_ada[l], 6, axis=-1)
        mc = jnp.split(jax.nn.silu(c_ctx) @ w_ada[l] + b_ada[l], 6, axis=-1)
        log_gamma = jax.nn.log_sigmoid(ret_decay_logit[l].astype(F32))
        mixer_w = (hy_conv_w[l], hy_conv_b[l], hy_f_w1[l], hy_f_b1[l], hy_f_freq1[l], hy_f_w2[l],
                   hy_f_b2[l], hy_f_freq2[l], hy_f_w3[l], hy_bias[l], log_gamma, ret_gn_g[l])
        hx = _modulate(_rmsnorm(x, norm1_g[l]), mx[0][:, None], mx[1][:, None])
        hc = _modulate(_rmsnorm(ctx, norm1_g[l]), mc[0], mc[1])
        ux = hx @ w_in[l]
        uc = hc @ w_in[l]
        kc, vc = _ret_kv(uc)
        s_f = _ret_final_state(kc, vc, log_gamma[0])
        s_b = _ret_final_state(jnp.flip(kc, 2), jnp.flip(vc, 2), log_gamma[1])
        mix_x = _token_mixers(ux, rope, s_f, s_b, *mixer_w)
        x_new = x + mx[2][:, None] * (mix_x @ w_out[l])
        hx2 = _modulate(_rmsnorm(x_new, norm2_g[l]), mx[3][:, None], mx[4][:, None])
        x_new = x_new + mx[5][:, None] * _sq_relu_mlp(hx2, w_mlp1[l], w_mlp2[l])
        if l < DEPTH - 1:
            zeros = jnp.zeros_like(s_f)
            mix_c = _token_mixers(uc, None, zeros, zeros, *mixer_w)
            ctx = ctx + mc[2] * (mix_c @ w_out[l])
            hc2 = _modulate(_rmsnorm(ctx, norm2_g[l]), mc[3], mc[4])
            ctx = ctx + mc[5] * _sq_relu_mlp(hc2, w_mlp1[l], w_mlp2[l])
        x = x_new
    return _rmsnorm(x, norm_f_g)
```

```cpp
#include <hip/hip_runtime.h>
#include <cstdio>
#include <cstdint>
#include <cmath>
namespace pg8 {
#define PG8_LAS __attribute__((address_space(3)))
typedef unsigned short bf16_t;
typedef short bf16x8 __attribute__((ext_vector_type(8)));
typedef float f32x4 __attribute__((ext_vector_type(4)));
typedef unsigned u32x4 __attribute__((ext_vector_type(4)));
constexpr int BM = 256, BK = 64, HALF = 128, HTB = HALF * BK * 2  , STAGE_BYTES = 8 * HTB, NXCD = 8, WGM = 8;

__host__ __device__ __forceinline__ int lds_byte(int r, int c) { const int st = (r >> 4) * 2 + (c >> 5), rr = r & 15, cc = c & 31, ob = rr * 64 + cc * 2; return st * 1024 + (ob ^ (((ob >> 9) & 1) << 5)); }
__host__ __device__ __forceinline__ void stage_rc(int b, int& R, int& C) { const int st = b / 1024, sb = b % 1024, swz = sb ^ (((sb >> 9) & 1) << 5); R = (st >> 1) * 16 + swz / 64; C = (st & 1) * 32 + (swz % 64) / 2; }
__host__ __device__ __forceinline__ int perm32(int rho) { const int n = rho >> 4, i = rho & 15; return 8 * (i >> 2) + 4 * n + (i & 3); }

struct Unit { int pm, pn; };
struct Gemm { const bf16_t* A; const bf16_t* Bt; int M, N, K; };

struct StaticOrder {
    int nM, nN, nwg, G, c;
    __host__ __device__ void init(int M, int N, int G_, int c_) { nM = M / BM; nN = N / BM; nwg = nM * nN; G = G_; c = c_; }
    __host__ __device__ bool next(int i, Unit& u) const {
        const long L = (long)i * G + c; if (L >= nwg) return false;
        int wgid = (int)L; { const int q = nwg / NXCD, r = nwg % NXCD, xcd = wgid % NXCD, off = wgid / NXCD; wgid = (xcd < r ? xcd * (q + 1) : r * (q + 1) + (xcd - r) * q) + off; }
        const int nig = WGM * nN, gid = wgid / nig, fm = gid * WGM, gsz = (nM - fm) < WGM ? (nM - fm) : WGM;
        u.pm = fm + ((wgid % nig) % gsz); u.pn = (wgid % nig) / gsz; return true;
    }
    __device__ __forceinline__ void a_ready(const Unit&) const {}
    __device__ __forceinline__ void done(const Unit&) const {}
};

__device__ __forceinline__ unsigned cvt_pk_bf16(float lo, float hi) { unsigned r; asm volatile("v_cvt_pk_bf16_f32 %0, %1, %2" : "=v"(r) : "v"(lo), "v"(hi)); return r; }
typedef float f32x2 __attribute__((ext_vector_type(2)));
__device__ __forceinline__ f32x2 gelu_pk(f32x2 v) {
    const f32x2 av = __builtin_elementwise_abs(v), d = av * 0.2316418882f + 1.0f;
    f32x2 t; t.x = __builtin_amdgcn_rcpf(d.x); t.y = __builtin_amdgcn_rcpf(d.y);
    f32x2 q = t * 0.5307027145f + (-0.7265760135f); q = q * t + 0.7107068705f; q = q * t + (-0.142248368f); q = q * t + 0.127414796f; q = q * t;
    const f32x2 s = (v * v) * (-0.72134752044f);
    f32x2 e; e.x = __builtin_amdgcn_exp2f(s.x); e.y = __builtin_amdgcn_exp2f(s.y);
    const f32x2 m = v * (q * e), r = v - m;
    f32x2 o; o.x = v.x < 0.f ? m.x : r.x; o.y = v.y < 0.f ? m.y : r.y; return o;
}

template <int ACT  > struct EpiBf16 {
    static constexpr bool PERM = true, AFTER_DRAIN = false; static_assert(ACT == 0 || ACT == 1 || ACT == 2, "EpiBf16: ACT is 0 (none), 1 (gelu_pk) or 2 (squared relu)");
    bf16_t* O; int ldc; const float* bias; int split_cols; size_t split_stride; float scale0; const float* rowss; int bias_bstride;
    __device__ __forceinline__ void operator()(const f32x4 (&acc)[2][2][4][2], const Unit& u, int wr, int wc, int fr, int fq) const {
        const int row0 = u.pm * BM + wr * 64 + fr; int colt = u.pn * BM; bf16_t* base = O;
        float sc = 1.f; if (split_cols) { const int t = colt / split_cols; base += (size_t)t * split_stride; colt -= t * split_cols; if (t == 0) sc = scale0; }
        const int col0 = colt + wc * 32 + 8 * fq, bcol0 = u.pn * BM + wc * 32 + 8 * fq;
        f32x4 bv[2][2];
#pragma unroll
        for (int bj = 0; bj < 2; ++bj)
#pragma unroll
            for (int n = 0; n < 2; ++n) bv[bj][n] = bias ? *(const f32x4*)(bias + (size_t)(u.pm >> 5) * bias_bstride + bcol0 + bj * HALF + 4 * n) : (f32x4){0.f, 0.f, 0.f, 0.f};
#pragma unroll
        for (int ai = 0; ai < 2; ++ai)
#pragma unroll
            for (int m = 0; m < 4; ++m) { bf16_t* rowp = base + (size_t)(row0 + ai * HALF + m * 16) * ldc + col0; const float rs = rowss ? 1.0f / sqrtf(rowss[row0 + ai * HALF + m * 16] * (1.0f / 1024.0f) + 1e-6f) : 1.0f;
#pragma unroll
                for (int bj = 0; bj < 2; ++bj) { f32x4 v0 = acc[ai][bj][m][0] * rs + bv[bj][0], v1 = acc[ai][bj][m][1] * rs + bv[bj][1];
                    if (ACT == 1) { f32x2 a = gelu_pk((f32x2){v0[0], v0[1]}), b = gelu_pk((f32x2){v0[2], v0[3]}), c = gelu_pk((f32x2){v1[0], v1[1]}), d = gelu_pk((f32x2){v1[2], v1[3]});
                        v0 = (f32x4){a.x, a.y, b.x, b.y}; v1 = (f32x4){c.x, c.y, d.x, d.y}; }
                    if (ACT == 2) { v0 = __builtin_elementwise_max(v0, (f32x4){0.f, 0.f, 0.f, 0.f}); v1 = __builtin_elementwise_max(v1, (f32x4){0.f, 0.f, 0.f, 0.f}); v0 = v0 * v0; v1 = v1 * v1; }
                    v0 = v0 * sc; v1 = v1 * sc; u32x4 w; w.x = cvt_pk_bf16(v0[0], v0[1]); w.y = cvt_pk_bf16(v0[2], v0[3]); w.z = cvt_pk_bf16(v1[0], v1[1]); w.w = cvt_pk_bf16(v1[2], v1[3]);
                    *(u32x4*)(rowp + bj * HALF) = w; } }
    }
};
struct EpiResF32 {
    static constexpr bool PERM = false, AFTER_DRAIN = false;
    const float* base; float* out; const float* gate; int ldc;
    __device__ __forceinline__ void operator()(const f32x4 (&acc)[2][2][4][2], const Unit& u, int wr, int wc, int fr, int fq) const {
        const float* g = gate + (size_t)(u.pm >> 5) * 6144;
        const int col0 = u.pn * BM + wc * 32 + 4 * fq;
        f32x4 gv[2][2];
#pragma unroll
        for (int bj = 0; bj < 2; ++bj)
#pragma unroll
            for (int n = 0; n < 2; ++n) gv[bj][n] = *(const f32x4*)(g + col0 + bj * HALF + n * 16);
#pragma unroll
        for (int ai = 0; ai < 2; ++ai) {
            f32x4 bs[4][2][2];
#pragma unroll
            for (int m = 0; m < 4; ++m) { const size_t off = (size_t)(u.pm * BM + ai * HALF + wr * 64 + m * 16 + fr) * ldc + col0;
#pragma unroll
                for (int bj = 0; bj < 2; ++bj)
#pragma unroll
                    for (int n = 0; n < 2; ++n) bs[m][bj][n] = *(const f32x4*)(base + off + bj * HALF + n * 16); }
#pragma unroll
            for (int m = 0; m < 4; ++m) { const size_t off = (size_t)(u.pm * BM + ai * HALF + wr * 64 + m * 16 + fr) * ldc + col0;
#pragma unroll
                for (int bj = 0; bj < 2; ++bj)
#pragma unroll
                    for (int n = 0; n < 2; ++n) *(f32x4*)(out + off + bj * HALF + n * 16) = bs[m][bj][n] + gv[bj][n] * acc[ai][bj][m][n]; }
            asm volatile("" ::: "memory"); }
    }
};

struct EpiResF32Ln {
    static constexpr bool PERM = false, AFTER_DRAIN = false;
    const float* base; float* out; const float* gate; int ldc; const float* gm; bf16_t* xg; float* rowss;
    __device__ __forceinline__ void operator()(const f32x4 (&acc)[2][2][4][2], const Unit& u, int wr, int wc, int fr, int fq) const {
        typedef unsigned u32x2v __attribute__((ext_vector_type(2)));
        const float* g = gate + (size_t)(u.pm >> 5) * 6144; const float* gmb = gm + (size_t)(u.pm >> 5) * 1024;
        const int col0 = u.pn * BM + wc * 32 + 4 * fq;
        f32x4 gv[2][2], mv[2][2];
#pragma unroll
        for (int bj = 0; bj < 2; ++bj)
#pragma unroll
            for (int n = 0; n < 2; ++n) { gv[bj][n] = *(const f32x4*)(g + col0 + bj * HALF + n * 16); mv[bj][n] = *(const f32x4*)(gmb + col0 + bj * HALF + n * 16); }
#pragma unroll
        for (int ai = 0; ai < 2; ++ai)
#pragma unroll
            for (int mp = 0; mp < 4; mp += 2) {
                f32x4 bsv[2][2][2];
#pragma unroll
                for (int mm = 0; mm < 2; ++mm) { const size_t off = (size_t)(u.pm * BM + ai * HALF + wr * 64 + (mp + mm) * 16 + fr) * ldc + col0;
#pragma unroll
                    for (int bj = 0; bj < 2; ++bj)
#pragma unroll
                        for (int n = 0; n < 2; ++n) bsv[mm][bj][n] = *(const f32x4*)(base + off + bj * HALF + n * 16); }
#pragma unroll
                for (int mm = 0; mm < 2; ++mm) { const int m = mp + mm; const int row = u.pm * BM + ai * HALF + wr * 64 + m * 16 + fr; const size_t off = (size_t)row * ldc + col0; float ss = 0.f;
#pragma unroll
                    for (int bj = 0; bj < 2; ++bj)
#pragma unroll
                        for (int n = 0; n < 2; ++n) { const f32x4 o = bsv[mm][bj][n] + gv[bj][n] * acc[ai][bj][m][n];
                            *(f32x4*)(out + off + bj * HALF + n * 16) = o;
                            ss += (o.x * o.x + o.y * o.y) + (o.z * o.z + o.w * o.w);
                            const f32x4 y = o * mv[bj][n]; u32x2v w; w.x = cvt_pk_bf16(y.x, y.y); w.y = cvt_pk_bf16(y.z, y.w);
                            *(u32x2v*)(xg + off + bj * HALF + n * 16) = w; }
                    ss += __shfl_xor(ss, 16); ss += __shfl_xor(ss, 32);
                    if (fq == 0) atomicAdd(rowss + row, ss); }
                asm volatile("" ::: "memory"); }
    }
};

struct PanelOrder {
    int G, c, nM;
    __host__ __device__ void init(int M, int G_, int c_) { nM = M / BM; G = G_; c = c_; }
    __host__ __device__ bool next(int i, Unit& u) const { const int pm = c + (i >> 2) * G; if (pm >= nM) return false; u.pm = pm; u.pn = i & 3; return true; }
    __device__ __forceinline__ void a_ready(const Unit&) const {}
    __device__ __forceinline__ void done(const Unit&) const {}
};
struct EpiResF32Fin {
    static constexpr bool PERM = false, AFTER_DRAIN = false;
    const float* base; float* out; const float* gate; int ldc; const float* gf; PG8_LAS float* rs;
    __device__ __forceinline__ void operator()(const f32x4 (&acc)[2][2][4][2], const Unit& u, int wr, int wc, int fr, int fq) const {
        const float* g = gate + (size_t)(u.pm >> 5) * 6144;
        const int col0 = u.pn * BM + wc * 32 + 4 * fq;
        f32x4 gv[2][2];
#pragma unroll
        for (int bj = 0; bj < 2; ++bj)
#pragma unroll
            for (int n = 0; n < 2; ++n) gv[bj][n] = *(const f32x4*)(g + col0 + bj * HALF + n * 16);
#pragma unroll
        for (int ai = 0; ai < 2; ++ai)
#pragma unroll
            for (int m = 0; m < 4; ++m) { const int rl = ai * HALF + wr * 64 + m * 16 + fr; const size_t off = (size_t)(u.pm * BM + rl) * ldc + col0; float ss = 0.f;
#pragma unroll
                for (int bj = 0; bj < 2; ++bj)
#pragma unroll
                    for (int n = 0; n < 2; ++n) { const f32x4 bs = *(const f32x4*)(base + off + bj * HALF + n * 16);
                        const f32x4 o = bs + gv[bj][n] * acc[ai][bj][m][n];
                        *(f32x4*)(out + off + bj * HALF + n * 16) = o;
                        ss += (o.x * o.x + o.y * o.y) + (o.z * o.z + o.w * o.w); }
                ss += __shfl_xor(ss, 16); ss += __shfl_xor(ss, 32);
                if (fq == 0) __hip_atomic_fetch_add((float*)(rs + rl), ss, __ATOMIC_RELAXED, __HIP_MEMORY_SCOPE_WORKGROUP);
                if (m & 1) asm volatile("" ::: "memory"); }
        if (u.pn == 3) {
            asm volatile("s_waitcnt vmcnt(0) lgkmcnt(0)" ::: "memory"); __builtin_amdgcn_s_barrier(); asm volatile("" ::: "memory");
            const int lane = fr + 16 * fq, wid = wr * 4 + wc;
            for (int i = 0; i < 32; i += 2) { const int r0 = wid * 32 + i;
                f32x4* pa = (f32x4*)(out + (size_t)(u.pm * BM + r0) * ldc) + lane; f32x4* pb = pa + ldc / 4;
                f32x4 va[4], vb[4];
#pragma unroll
                for (int j = 0; j < 4; ++j) { va[j] = pa[64 * j]; vb[j] = pb[64 * j]; }
                const float ra = 1.0f / sqrtf(rs[r0] * (1.0f / 1024.0f) + 1e-6f), rb = 1.0f / sqrtf(rs[r0 + 1] * (1.0f / 1024.0f) + 1e-6f);
#pragma unroll
                for (int j = 0; j < 4; ++j) { const f32x4 gg = *(const f32x4*)(gf + 4 * lane + 256 * j); pa[64 * j] = va[j] * ra * gg; pb[64 * j] = vb[j] * rb * gg; } }
            asm volatile("s_waitcnt lgkmcnt(0)" ::: "memory"); __builtin_amdgcn_s_barrier(); asm volatile("" ::: "memory");
            if (wid * 64 + lane < 256) rs[wid * 64 + lane] = 0.f;
            asm volatile("s_waitcnt lgkmcnt(0)" ::: "memory"); __builtin_amdgcn_s_barrier(); asm volatile("" ::: "memory");
        }
    }
};

struct RevStaticOrder {
    StaticOrder S;
    __host__ __device__ void init(int M, int N, int G_, int c_) { S.init(M, N, G_, c_); }
    __host__ __device__ bool next(int i, Unit& u) const { if (!S.next(i, u)) return false; u.pm = S.nM - 1 - u.pm; return true; }
    __device__ __forceinline__ void a_ready(const Unit&) const {}
    __device__ __forceinline__ void done(const Unit&) const {}
};

struct EpiGateBf16 {
    static constexpr bool PERM = true, AFTER_DRAIN = false;
    bf16_t* O; int ldc; const float* gate;
    __device__ __forceinline__ void operator()(const f32x4 (&acc)[2][2][4][2], const Unit& u, int wr, int wc, int fr, int fq) const {
        const int row0 = u.pm * BM + wr * 64 + fr, col0 = u.pn * BM + wc * 32 + 8 * fq;
        const float* g = gate + (size_t)(u.pm >> 5) * 6144;
        f32x4 gv[2][2];
#pragma unroll
        for (int bj = 0; bj < 2; ++bj)
#pragma unroll
            for (int n = 0; n < 2; ++n) gv[bj][n] = *(const f32x4*)(g + col0 + bj * HALF + 4 * n);
#pragma unroll
        for (int ai = 0; ai < 2; ++ai)
#pragma unroll
            for (int m = 0; m < 4; ++m) { bf16_t* rowp = O + (size_t)(row0 + ai * HALF + m * 16) * ldc + col0;
#pragma unroll
                for (int bj = 0; bj < 2; ++bj) { const f32x4 v0 = acc[ai][bj][m][0] * gv[bj][0], v1 = acc[ai][bj][m][1] * gv[bj][1];
                    u32x4 w; w.x = cvt_pk_bf16(v0[0], v0[1]); w.y = cvt_pk_bf16(v0[2], v0[3]); w.z = cvt_pk_bf16(v1[0], v1[1]); w.w = cvt_pk_bf16(v1[2], v1[3]);
                    *(u32x4*)(rowp + bj * HALF) = w; } }
    }
};

template <class Epi, class Sched, bool ALIGN_EPI = false, bool SP2 = false>
__device__ __forceinline__ void gemm_phase(PG8_LAS unsigned char* lds, const Gemm g, const Sched& S, const Epi& E) {
    const int tid = threadIdx.x, wid = __builtin_amdgcn_readfirstlane(tid >> 6), lane = tid & 63, wr = wid >> 2, wc = wid & 3, fr = lane & 15, fq = lane >> 4;
    const int K = g.K, nt = K / BK;
    unsigned voffA[2], voffB[2];
#pragma unroll
    for (int i = 0; i < 2; ++i) { int R, C; stage_rc(tid * 16 + i * 8192, R, C); const int Rb = Epi::PERM ? ((R & ~31) + perm32(R & 31)) : R;
        voffA[i] = (unsigned)(R * K + C) * 2u; voffB[i] = (unsigned)(Rb * K + C) * 2u; }
    const size_t kstep = (size_t)(BK * 2);
    const size_t hstep = (size_t)HALF * K * 2;
    const size_t tstep = 2 * hstep;
    const unsigned ldsw = (unsigned)wid * 1024u;
    const int aoff = lds_byte(wr * 64 + fr, fq * 8), boff = lds_byte(wc * 32 + fr, fq * 8);
#define PG8_SA(b, h) (((b) * 2 + (h)) * HTB)
#define PG8_SB(b, h) ((4 + (b) * 2 + (h)) * HTB)
#define PG8_STAGE(bufoff, gbase, voff) do { _Pragma("unroll") for (int _i = 0; _i < 2; ++_i) \
        __builtin_amdgcn_global_load_lds((const unsigned*)((const char*)(gbase) + (voff)[_i]), (PG8_LAS unsigned*)(lds + (bufoff) + ldsw + _i * 8192), 16, 0, 0); } while (0)
#define PG8_LDA(dst, b, h) do { _Pragma("unroll") for (int m = 0; m < 4; ++m) _Pragma("unroll") for (int k = 0; k < 2; ++k) dst[m][k] = *(const PG8_LAS bf16x8*)(lds + PG8_SA(b, h) + aoff + m * 2048 + k * 1024); } while (0)
#define PG8_LDB(dst, b, h) do { _Pragma("unroll") for (int n = 0; n < 2; ++n) _Pragma("unroll") for (int k = 0; k < 2; ++k) dst[n][k] = *(const PG8_LAS bf16x8*)(lds + PG8_SB(b, h) + boff + n * 2048 + k * 1024); } while (0)
#define PG8_MMA(ai, bj, At, Bt) do { __builtin_amdgcn_s_setprio(1); _Pragma("unroll") for (int m = 0; m < 4; ++m) _Pragma("unroll") for (int n = 0; n < 2; ++n) _Pragma("unroll") for (int k = 0; k < 2; ++k) \
        acc[ai][bj][m][n] = __builtin_amdgcn_mfma_f32_16x16x32_bf16(Bt[n][k], At[m][k], acc[ai][bj][m][n], 0, 0, 0); __builtin_amdgcn_s_setprio(0); } while (0)
#define PG8_WAIT_V(n) asm volatile("s_waitcnt vmcnt(" #n ")" ::: "memory")
#define PG8_WAIT_L(n) asm volatile("s_waitcnt lgkmcnt(" #n ")" ::: "memory")
#define PG8_BAR __builtin_amdgcn_s_barrier()
#define PG8_SCHED __builtin_amdgcn_sched_barrier(0)
    Unit cur, nxt; int ui = 0;
    if (!S.next(0, cur)) return;
    f32x4 acc[2][2][4][2];
#pragma unroll
    for (int a = 0; a < 2; ++a)
#pragma unroll
        for (int b = 0; b < 2; ++b)
#pragma unroll
            for (int m = 0; m < 4; ++m)
#pragma unroll
                for (int n = 0; n < 2; ++n) acc[a][b][m][n] = (f32x4){0.f, 0.f, 0.f, 0.f};
    bf16x8 At[4][2], B0[2][2], B1[2][2];
    const char* cA = (const char*)g.A + (size_t)cur.pm * tstep; const char* cB = (const char*)g.Bt + (size_t)cur.pn * tstep;
    S.a_ready(cur);
    if constexpr (SP2) {
        PG8_STAGE(PG8_SB(0, 0), cB, voffB); PG8_STAGE(PG8_SB(0, 1), cB + hstep, voffB); PG8_STAGE(PG8_SA(0, 0), cA, voffA); PG8_STAGE(PG8_SA(0, 1), cA + hstep, voffA);
        if (wr == 1) PG8_BAR;
        PG8_WAIT_V(2); PG8_BAR;
        PG8_STAGE(PG8_SB(1, 0), cB + kstep, voffB); PG8_STAGE(PG8_SA(1, 0), cA + kstep, voffA); PG8_STAGE(PG8_SB(1, 1), cB + hstep + kstep, voffB);
        PG8_WAIT_V(6); PG8_BAR;
    } else {
        PG8_STAGE(PG8_SB(0, 0), cB, voffB); PG8_STAGE(PG8_SA(0, 0), cA, voffA); PG8_STAGE(PG8_SB(0, 1), cB + hstep, voffB); PG8_STAGE(PG8_SA(0, 1), cA + hstep, voffA);
        if (wr == 1) PG8_BAR;
        PG8_WAIT_V(4); PG8_BAR;
        PG8_STAGE(PG8_SB(1, 0), cB + kstep, voffB); PG8_STAGE(PG8_SA(1, 0), cA + kstep, voffA); PG8_STAGE(PG8_SB(1, 1), cB + hstep + kstep, voffB);
        PG8_WAIT_V(6); PG8_BAR;
    }
    for (;;) {
        const bool has_next = S.next(ui + 1, nxt);
        const char* nA = has_next ? (const char*)g.A + (size_t)nxt.pm * tstep : cA; const char* nB = has_next ? (const char*)g.Bt + (size_t)nxt.pn * tstep : cB;
        for (int t = 0; t < nt; t += 2) {
            const bool last = (t == nt - 2);
            const char* a1 = cA + (size_t)(t + 1) * kstep;
            const char* a2 = last ? nA : cA + (size_t)(t + 2) * kstep; const char* b2 = last ? nB : cB + (size_t)(t + 2) * kstep;
            const char* a3 = a2 + kstep; const char* b3 = b2 + kstep;
            if (last && has_next) S.a_ready(nxt);
            if constexpr (SP2) {
            PG8_LDB(B0, 0, 0); PG8_LDB(B1, 0, 1); PG8_SCHED; PG8_LDA(At, 0, 0); PG8_STAGE(PG8_SA(1, 1), a1 + hstep, voffA);
            PG8_WAIT_V(8); PG8_WAIT_L(0); PG8_BAR; PG8_MMA(0, 0, At, B0); PG8_MMA(0, 1, At, B1); PG8_BAR; PG8_SCHED;
            PG8_LDA(At, 0, 1); PG8_STAGE(PG8_SB(0, 0), b2, voffB); PG8_STAGE(PG8_SB(0, 1), b2 + hstep, voffB); PG8_STAGE(PG8_SA(0, 0), a2, voffA);
            PG8_WAIT_V(8); PG8_WAIT_L(0); PG8_BAR; PG8_MMA(1, 0, At, B0); PG8_MMA(1, 1, At, B1); PG8_BAR; PG8_SCHED;
            PG8_LDB(B0, 1, 0); PG8_LDB(B1, 1, 1); PG8_SCHED; PG8_LDA(At, 1, 0); PG8_STAGE(PG8_SA(0, 1), a2 + hstep, voffA);
            PG8_WAIT_V(8); PG8_WAIT_L(0); PG8_BAR; PG8_MMA(0, 0, At, B0); PG8_MMA(0, 1, At, B1); PG8_BAR; PG8_SCHED;
            PG8_LDA(At, 1, 1); PG8_STAGE(PG8_SB(1, 0), b3, voffB); PG8_STAGE(PG8_SB(1, 1), b3 + hstep, voffB); PG8_STAGE(PG8_SA(1, 0), a3, voffA);
            PG8_WAIT_V(8); PG8_WAIT_L(0); PG8_BAR; PG8_MMA(1, 0, At, B0); PG8_MMA(1, 1, At, B1); PG8_BAR; PG8_SCHED;
            } else {
            PG8_LDB(B0, 0, 0); PG8_SCHED; PG8_LDA(At, 0, 0); PG8_STAGE(PG8_SA(1, 1), a1 + hstep, voffA);
            PG8_WAIT_L(8); PG8_BAR; PG8_WAIT_L(0); PG8_MMA(0, 0, At, B0); PG8_BAR; PG8_SCHED;
            PG8_LDB(B1, 0, 1); PG8_STAGE(PG8_SB(0, 0), b2, voffB);
            PG8_BAR; PG8_WAIT_L(0); PG8_MMA(0, 1, At, B1); PG8_BAR;
            PG8_LDA(At, 0, 1); PG8_STAGE(PG8_SA(0, 0), a2, voffA);
            PG8_BAR; PG8_WAIT_L(0); PG8_MMA(1, 0, At, B0); PG8_BAR; PG8_SCHED;
            PG8_STAGE(PG8_SB(0, 1), b2 + hstep, voffB);
            PG8_WAIT_V(6); PG8_BAR; PG8_MMA(1, 1, At, B1); PG8_BAR;
            PG8_LDB(B0, 1, 0); PG8_SCHED; PG8_LDA(At, 1, 0); PG8_STAGE(PG8_SA(0, 1), a2 + hstep, voffA);
            PG8_WAIT_L(8); PG8_BAR; PG8_WAIT_L(0); PG8_MMA(0, 0, At, B0); PG8_BAR; PG8_SCHED;
            PG8_LDB(B1, 1, 1); PG8_STAGE(PG8_SB(1, 0), b3, voffB);
            PG8_BAR; PG8_WAIT_L(0); PG8_MMA(0, 1, At, B1); PG8_BAR;
            PG8_LDA(At, 1, 1); PG8_STAGE(PG8_SA(1, 0), a3, voffA);
            PG8_BAR; PG8_WAIT_L(0); PG8_MMA(1, 0, At, B0); PG8_BAR; PG8_SCHED;
            PG8_STAGE(PG8_SB(1, 1), b3 + hstep, voffB);
            PG8_WAIT_V(6); PG8_BAR; PG8_MMA(1, 1, At, B1); PG8_BAR;
            }
        }
        if constexpr (ALIGN_EPI) { if (wr == 0) PG8_BAR; }
        if constexpr (!Epi::AFTER_DRAIN) { E(acc, cur, wr, wc, fr, fq); S.done(cur); }
        if (!has_next) break;
#pragma unroll
        for (int a = 0; a < 2; ++a)
#pragma unroll
            for (int b = 0; b < 2; ++b)
#pragma unroll
                for (int m = 0; m < 4; ++m)
#pragma unroll
                    for (int n = 0; n < 2; ++n) acc[a][b][m][n] = (f32x4){0.f, 0.f, 0.f, 0.f};
        cur = nxt; cA = nA; cB = nB; ++ui;
        if constexpr (ALIGN_EPI) { if (wr == 1) PG8_BAR; }
    }
    PG8_WAIT_V(0);
    if constexpr (!ALIGN_EPI) { if (wr == 0) PG8_BAR; }
    PG8_BAR;
    if constexpr (Epi::AFTER_DRAIN) { E.fused(acc, cur, wr, wc, fr, fq, lds, wid, lane); S.done(cur); }
#undef PG8_SA
#undef PG8_SB
#undef PG8_STAGE
#undef PG8_LDA
#undef PG8_LDB
#undef PG8_MMA
#undef PG8_WAIT_V
#undef PG8_WAIT_L
#undef PG8_BAR
#undef PG8_SCHED
}
}
#define FFT_DEV __device__ __forceinline__
typedef float cf __attribute__((ext_vector_type(2)));
#ifdef FFT_HOST
#define FFT_TIE(a, b) do {} while (0)
#define FFT_STAGE_FENCE() do {} while (0)
FFT_DEV cf cmul(cf a, cf b) { cf r; r.x = a.x * b.x - a.y * b.y; r.y = a.x * b.y + a.y * b.x; return r; }
FFT_DEV cf cmulc(cf a, cf b) { cf r; r.x = a.x * b.x + a.y * b.y; r.y = a.y * b.x - a.x * b.y; return r; }
FFT_DEV cf crot_mi(cf a) { cf r; r.x = a.y; r.y = -a.x; return r; }
FFT_DEV cf crot_pi(cf a) { cf r; r.x = -a.y; r.y = a.x; return r; }
#else
#define FFT_TIE(a, b) asm volatile("" : "+v"(a), "+v"(b))
#define FFT_STAGE_FENCE() __builtin_amdgcn_sched_barrier(0)
FFT_DEV cf cmul(cf a, cf w) { cf t, r;
    asm("v_pk_mul_f32 %0, %1, %2 op_sel:[0,0] op_sel_hi:[0,1]" : "=v"(t) : "v"(a), "v"(w));
    asm("v_pk_fma_f32 %0, %1, %2, %3 op_sel:[1,1,0] op_sel_hi:[1,0,1] neg_lo:[0,1,0] neg_hi:[0,0,0]" : "=v"(r) : "v"(a), "v"(w), "v"(t));
    return r; }
FFT_DEV cf cmulc(cf a, cf w) { cf t, r;
    asm("v_pk_mul_f32 %0, %1, %2 op_sel:[0,0] op_sel_hi:[0,1] neg_lo:[0,0] neg_hi:[0,1]" : "=v"(t) : "v"(a), "v"(w));
    asm("v_pk_fma_f32 %0, %1, %2, %3 op_sel:[1,1,0] op_sel_hi:[1,0,1]" : "=v"(r) : "v"(a), "v"(w), "v"(t));
    return r; }
FFT_DEV cf crot_mi(cf a) { cf r; const cf one = {1.0f, 1.0f};
    asm("v_pk_mul_f32 %0, %1, %2 op_sel:[1,0] op_sel_hi:[0,1] neg_lo:[0,0] neg_hi:[1,0]" : "=v"(r) : "v"(a), "v"(one)); return r; }
FFT_DEV cf crot_pi(cf a) { cf r; const cf one = {1.0f, 1.0f};
    asm("v_pk_mul_f32 %0, %1, %2 op_sel:[1,0] op_sel_hi:[0,1] neg_lo:[1,0] neg_hi:[0,0]" : "=v"(r) : "v"(a), "v"(one)); return r; }
#endif
FFT_DEV cf cadd(cf a, cf b) { return a + b; }
FFT_DEV cf csub(cf a, cf b) { return a - b; }
#define FFT_C32 {1.0f, 0.98078528040323043f, 0.92387953251128674f, 0.83146961230254524f, 0.70710678118654757f, 0.55557023301960229f, 0.38268343236508984f, 0.19509032201612833f, \
                 0.0f, -0.19509032201612833f, -0.38268343236508984f, -0.55557023301960229f, -0.70710678118654757f, -0.83146961230254524f, -0.92387953251128674f, -0.98078528040323043f, \
                 -1.0f, -0.98078528040323043f, -0.92387953251128674f, -0.83146961230254524f, -0.70710678118654757f, -0.55557023301960229f, -0.38268343236508984f, -0.19509032201612833f, \
                 0.0f, 0.19509032201612833f, 0.38268343236508984f, 0.55557023301960229f, 0.70710678118654757f, 0.83146961230254524f, 0.92387953251128674f, 0.98078528040323043f}
#define FFT_S32 {0.0f, 0.19509032201612833f, 0.38268343236508984f, 0.55557023301960229f, 0.70710678118654757f, 0.83146961230254524f, 0.92387953251128674f, 0.98078528040323043f, \
                 1.0f, 0.98078528040323043f, 0.92387953251128674f, 0.83146961230254524f, 0.70710678118654757f, 0.55557023301960229f, 0.38268343236508984f, 0.19509032201612833f, \
                 0.0f, -0.19509032201612833f, -0.38268343236508984f, -0.55557023301960229f, -0.70710678118654757f, -0.83146961230254524f, -0.92387953251128674f, -0.98078528040323043f, \
                 -1.0f, -0.98078528040323043f, -0.92387953251128674f, -0.83146961230254524f, -0.70710678118654757f, -0.55557023301960229f, -0.38268343236508984f, -0.19509032201612833f}
FFT_DEV int fphys(int i) { return (i & ~15) + ((i ^ (i >> 4)) & 15) + ((i >> 9) << 4); }
constexpr int FFT_SLOTS = 16384 + 32 * 16;

template <int G, bool UPPER_ZERO = false> FFT_DEV void fft_fwd_group(cf (&r)[1 << G]) {
    constexpr float C32[32] = FFT_C32; constexpr float S32[32] = FFT_S32;
#pragma unroll
    for (int q = G - 1; q >= 0; --q) {
#pragma unroll
        for (int j = 0; j < (1 << G); ++j) {
            if (j & (1 << q)) continue;
            const int jm = j & ((1 << q) - 1), ti = jm << (4 - q);
            const bool zp = UPPER_ZERO && q == G - 1;
            const cf a = r[j], b = zp ? a : r[j + (1 << q)];
            if (!zp) r[j] = cadd(a, b);
            const cf d = zp ? a : csub(a, b);
            cf o;
            if (ti == 0) o = d;
            else if (ti == 8) o = crot_mi(d);
            else { const cf w = {C32[ti], -S32[ti]}; o = cmul(d, w); }
            r[j + (1 << q)] = o;
        }
        FFT_STAGE_FENCE();
    }
}
template <int G, bool LOWER_ONLY = false> FFT_DEV void fft_inv_group(cf (&r)[1 << G]) {
    constexpr float C32[32] = FFT_C32; constexpr float S32[32] = FFT_S32;
#pragma unroll
    for (int q = 0; q < G; ++q) {
#pragma unroll
        for (int j = 0; j < (1 << G); ++j) {
            if (j & (1 << q)) continue;
            const int jm = j & ((1 << q) - 1), ti = jm << (4 - q);
            const cf a = r[j];
            cf b = r[j + (1 << q)];
            if (ti == 0) {}
            else if (ti == 8) b = crot_pi(b);
            else { const cf w = {C32[ti], -S32[ti]}; b = cmulc(b, w); }
            r[j] = cadd(a, b);
            if (!(LOWER_ONLY && q == G - 1)) r[j + (1 << q)] = csub(a, b);
        }
        FFT_STAGE_FENCE();
    }
}
#ifdef FFT_HOST
FFT_DEV int fft_opaque(int v) { return v; }
FFT_DEV cf fft_opaque_cf(cf v) { return v; }
#else
FFT_DEV int fft_opaque(int v) { asm volatile("" : "+v"(v)); return v; }
FFT_DEV cf fft_opaque_cf(cf v) { asm volatile("" : "+v"(v)); return v; }
#endif
FFT_DEV void fft_make_tw(int tid, cf& wA, cf& wB) {
    float s, c;
    sincosf(-6.283185307179586f * (float)tid / 16384.0f, &s, &c); wA.x = c; wA.y = s;
    sincosf(-6.283185307179586f * (float)(tid & 15) / 512.0f, &s, &c); wB.x = c; wB.y = s;
}
FFT_DEV constexpr int fft_brev5(int k) { return ((k & 1) << 4) | ((k & 2) << 2) | (k & 4) | ((k & 8) >> 2) | ((k & 16) >> 4); }
template <bool INV, bool HALF = false> FFT_DEV void fft_r32(cf (&r)[32], cf w1) {
    if (!INV) { fft_fwd_group<5, HALF>(r); FFT_TIE(w1, r[0]); }
    cf wk = w1;
#pragma unroll
    for (int k = 1; k < 32; ++k) { r[fft_brev5(k)] = INV ? cmulc(r[fft_brev5(k)], wk) : cmul(r[fft_brev5(k)], wk); if (k < 31) wk = cmul(wk, w1);
        if ((k & 3) == 3) FFT_TIE(wk, r[fft_brev5(k)]); }
    if (INV) fft_inv_group<5, HALF>(r);
}
template <bool INV, bool HALF = false> FFT_DEV void fft_passA(cf* Z, int tid_, cf wA) {
    cf r[32]; const int tid = fft_opaque(tid_); const cf w1 = fft_opaque_cf(wA);
    cf* Zp = Z + fphys(tid);
#pragma unroll
    for (int j = 0; j < ((HALF && !INV) ? 16 : 32); ++j) r[j] = Zp[528 * j];
    if (HALF && !INV) {
#pragma unroll
        for (int j = 16; j < 32; ++j) r[j] = (cf){0.f, 0.f};
    }
    fft_r32<INV, HALF>(r, w1);
#pragma unroll
    for (int j = 0; j < ((HALF && INV) ? 16 : 32); ++j) Zp[528 * j] = r[j];
}
template <bool INV> FFT_DEV void fft_passB(cf* Z, int tid_, cf wB) {
    cf r[32]; const int tid = fft_opaque(tid_); const cf w1 = fft_opaque_cf(wB);
    cf* Zp = Z + (tid >> 4) * 528; const int lo4 = tid & 15;
#pragma unroll
    for (int j = 0; j < 32; ++j) r[j] = Zp[16 * j + (lo4 ^ (j & 15))];
    fft_r32<INV>(r, w1);
#pragma unroll
    for (int j = 0; j < 32; ++j) Zp[16 * j + (lo4 ^ (j & 15))] = r[j];
}
FFT_DEV void fft_passC_fwd_store(const cf* Z, int tid_, int s, cf* kfg) {
    const int tid = fft_opaque(tid_);
    cf r[16];
    const int g = (tid >> 6) * 128 + (tid & 63) + 64 * s; const cf* Zp = Z + 16 * g + 16 * (g >> 5); const int g4 = g & 15;
#pragma unroll
    for (int j = 0; j < 16; ++j) r[j] = Zp[j ^ g4];
    fft_fwd_group<4>(r);
#pragma unroll
    for (int j = 0; j < 16; ++j) kfg[(s * 16 + j) * 512 + tid] = r[j];
}
FFT_DEV void fft_passC_mul(cf* Z, int tid_, int s, const cf* kfg) {
    const int tid = fft_opaque(tid_);
    cf r[16];
    const int g = (tid >> 6) * 128 + (tid & 63) + 64 * s; cf* Zp = Z + 16 * g + 16 * (g >> 5); const int g4 = g & 15;
#pragma unroll
    for (int j = 0; j < 16; ++j) r[j] = Zp[j ^ g4];
    fft_fwd_group<4>(r);
#pragma unroll
    for (int j = 0; j < 16; ++j) r[j] = cmul(r[j], kfg[(s * 16 + j) * 512 + tid]);
    fft_inv_group<4>(r);
#pragma unroll
    for (int j = 0; j < 16; ++j) Zp[j ^ g4] = r[j];
}
FFT_DEV void fft_passC_fwd_regs(const cf* Z, int tid_, int s, cf (&kf)[16]) {
    const int tid = fft_opaque(tid_);
    const int g = (tid >> 6) * 128 + (tid & 63) + 64 * s; const cf* Zp = Z + 16 * g + 16 * (g >> 5); const int g4 = g & 15;
#pragma unroll
    for (int j = 0; j < 16; ++j) kf[j] = Zp[j ^ g4];
    fft_fwd_group<4>(kf);
}
FFT_DEV void fft_passC_mul_regs(cf* Z, int tid_, int s, const cf (&kf)[16]) {
    const int tid = fft_opaque(tid_);
    cf r[16];
    const int g = (tid >> 6) * 128 + (tid & 63) + 64 * s; cf* Zp = Z + 16 * g + 16 * (g >> 5); const int g4 = g & 15;
#pragma unroll
    for (int j = 0; j < 16; ++j) r[j] = Zp[j ^ g4];
    fft_fwd_group<4>(r);
#pragma unroll
    for (int j = 0; j < 16; ++j) r[j] = cmul(r[j], kf[j]);
    fft_inv_group<4>(r);
#pragma unroll
    for (int j = 0; j < 16; ++j) Zp[j ^ g4] = r[j];
}
FFT_DEV float fft_bf2f(unsigned short u) { return __builtin_bit_cast(float, (unsigned)u << 16); }
FFT_DEV void fft_passA_fwd_in(cf* Z, int tid_, cf wA, const unsigned short (&in0)[16], const unsigned short (&in1)[16]) {
    cf r[32]; const int tid = fft_opaque(tid_); const cf w1 = fft_opaque_cf(wA);
    cf* Zp = Z + fphys(tid);
#pragma unroll
    for (int j = 0; j < 16; ++j) { r[j] = (cf){fft_bf2f(in0[j]), fft_bf2f(in1[j])}; r[j + 16] = (cf){0.f, 0.f}; }
    fft_r32<false, true>(r, w1);
#pragma unroll
    for (int j = 0; j < 32; ++j) Zp[528 * j] = r[j];
}
template <class PK> FFT_DEV void fft_passA_inv_out(const cf* Z, int tid_, cf wA, unsigned short* y0, unsigned short* y1, float scale, PK pk) {
    cf r[32]; const int tid = fft_opaque(tid_); const cf w1 = fft_opaque_cf(wA);
    const cf* Zp = Z + fphys(tid);
#pragma unroll
    for (int j = 0; j < 32; ++j) r[j] = Zp[528 * j];
    fft_r32<true, true>(r, w1);
#pragma unroll
    for (int j = 0; j < 16; ++j) { const unsigned w = pk(r[j].x * scale, r[j].y * scale); y0[tid + 512 * j] = (unsigned short)(w & 0xffffu); y1[tid + 512 * j] = (unsigned short)(w >> 16); }
}


#include <hip/hip_cooperative_groups.h>
namespace cg = cooperative_groups;
typedef unsigned short bf16;
typedef unsigned v4u __attribute__((ext_vector_type(4)));
typedef unsigned v2u __attribute__((ext_vector_type(2)));
typedef float f32x4 __attribute__((ext_vector_type(4)));
typedef short bf16x8 __attribute__((ext_vector_type(8)));
#define LAS __attribute__((address_space(3)))
#define GAS __attribute__((address_space(1)))
#ifndef MK_N_LAUNCHES
#define MK_N_LAUNCHES 1
#endif
constexpr int NWAVES = 8, NTHR = 512;
constexpr int D = 1024, SEQ = 8192, NTOK = 65536, NCTX = 2048, INC = 3584, FF = 4096, HYW = 512;
constexpr int NPHASE = 11;
constexpr size_t MiB = 1u << 20;
constexpr size_t WS_MXF = 0, WS_HPART = 1 * MiB, WS_ROPE = 2 * MiB, WS_WIN = 4 * MiB, WS_WOUT = 11 * MiB, WS_W1 = 13 * MiB, WS_W2 = 21 * MiB,
                 WS_HT = 32 * MiB, WS_HX = 64 * MiB, WS_T = 64 * MiB, WS_U = 196 * MiB, WS_UC = 644 * MiB, WS_VXT = 648 * MiB, WS_YT = 712 * MiB,
                 WS_S = 776 * MiB, WS_MIX = 840 * MiB, WS_HID = 196 * MiB, WS_END = 968 * MiB;
constexpr int LDS_BYTES = 147456;
constexpr size_t WS_CTL = 30 * MiB, CTL_BYTES = 16384;
constexpr size_t WS_ROWSS = 31 * MiB, WS_GM = 31 * MiB + 512 * 1024, WS_SB = 31 * MiB + 640 * 1024;
constexpr int LDS_BARST_OFF = LDS_BYTES - 64;
constexpr int FFT_SCR_OFF = FFT_SLOTS * 8;
static_assert(FFT_SCR_OFF + 1024 <= LDS_BYTES, "LDS map");

struct Params {
    const float *x, *c, *ctx, *c_ctx, *w_ada, *b_ada, *norm1_g, *w_in, *cw, *cb, *f_w1, *f_b1, *f_fr1, *f_w2, *f_b2, *f_fr2, *f_w3, *hy_bias, *decay_logit, *gn_g,
                *w_out, *norm2_g, *w_mlp1, *w_mlp2, *norm_f_g;
    float* out; unsigned char* ws; int ph_lo, ph_hi;
};

__device__ __forceinline__ unsigned f2bf(float f) { unsigned u = __builtin_bit_cast(unsigned, f); return (u + 0x7fffu + ((u >> 16) & 1u)) >> 16; }
typedef float f32x2_t __attribute__((ext_vector_type(2)));
typedef __bf16 bf16x2_t __attribute__((ext_vector_type(2)));
__device__ __forceinline__ unsigned pk2(float lo, float hi) { const f32x2_t v = {lo, hi}; const bf16x2_t r = __builtin_convertvector(v, bf16x2_t); return __builtin_bit_cast(unsigned, r); }
__device__ __forceinline__ float bflo(unsigned u) { return __builtin_bit_cast(float, u << 16); }
__device__ __forceinline__ float bfhi(unsigned u) { return __builtin_bit_cast(float, u & 0xffff0000u); }
__device__ __forceinline__ void unpack8(v4u a, float (&f)[8]) { f[0] = bflo(a.x); f[1] = bfhi(a.x); f[2] = bflo(a.y); f[3] = bfhi(a.y); f[4] = bflo(a.z); f[5] = bfhi(a.z); f[6] = bflo(a.w); f[7] = bfhi(a.w); }
__device__ __forceinline__ v4u pack8(const float (&f)[8]) { v4u o; o.x = pk2(f[0], f[1]); o.y = pk2(f[2], f[3]); o.z = pk2(f[4], f[5]); o.w = pk2(f[6], f[7]); return o; }
__device__ __forceinline__ float wave_sum(float v) {
#pragma unroll
    for (int o = 1; o < 64; o <<= 1) v += __shfl_xor(v, o);
    return v;
}
__device__ __forceinline__ float fexp2(float x) { return __builtin_amdgcn_exp2f(x); }
__device__ __forceinline__ float fsilu(float g) { return g * __builtin_amdgcn_rcpf(1.0f + __builtin_amdgcn_exp2f(-1.4426950408889634f * g)); }
__device__ __forceinline__ float log_gamma_of(float logit) { return -log1pf(expf(-logit)); }

__device__ __forceinline__ void p0_transpose_item(const float* W, int K, int N, bf16* WT, float* scr, int item, int lane) {
    const int nblk = N / 32, kb = item / nblk, nb = item % nblk, k0 = 64 * kb, n0 = 32 * nb;
    float wv[32];
#pragma unroll
    for (int i = 0; i < 32; ++i) wv[i] = W[(size_t)(k0 + 2 * i + (lane >> 5)) * N + n0 + (lane & 31)];
#pragma unroll
    for (int i = 0; i < 32; ++i) scr[(2 * i + (lane >> 5)) * 33 + (lane & 31)] = wv[i];
    __builtin_amdgcn_wave_barrier(); asm volatile("s_waitcnt lgkmcnt(0)" ::: "memory");
    const int c = lane & 7;
#pragma unroll
    for (int j = 0; j < 4; ++j) { const int n = (lane >> 3) + 8 * j; const float* s = scr + (8 * c) * 33 + n;
        v4u o; o.x = pk2(s[0 * 33], s[1 * 33]); o.y = pk2(s[2 * 33], s[3 * 33]); o.z = pk2(s[4 * 33], s[5 * 33]); o.w = pk2(s[6 * 33], s[7 * 33]);
        *(v4u*)(WT + (size_t)(n0 + n) * K + k0 + 8 * c) = o; }
    asm volatile("s_waitcnt lgkmcnt(0)" ::: "memory"); __builtin_amdgcn_wave_barrier();
}

__device__ __forceinline__ void phase0(const Params& P, unsigned char* lds, int tid, int lane, int wave) {
    const int G = gridDim.x, bid = blockIdx.x;
    float* ldsf = (float*)lds;
    float* mxf = (float*)(P.ws + WS_MXF);
    for (int it = bid; it < 256; it += G) {
        for (int i = tid; i < 9 * 1024; i += NTHR) { const int r = i >> 10, k = i & 1023; const float v = r < 8 ? P.c[r * 1024 + k] : P.c_ctx[k]; ldsf[i] = v / (1.f + expf(-v)); }
        __syncthreads();
        const int col0 = it * 24, col = tid % 24, kg = tid / 24;
        float acc[9];
#pragma unroll
        for (int r = 0; r < 9; ++r) acc[r] = 0.f;
        if (tid < 504) {
            float wv[49];
#pragma unroll
            for (int i = 0; i < 49; ++i) { const int k = kg + 21 * i; wv[i] = k < 1024 ? P.w_ada[(size_t)k * 6144 + col0 + col] : 0.f; }
#pragma unroll
            for (int i = 0; i < 49; ++i) { const int k = (kg + 21 * i) & 1023;
#pragma unroll
                for (int r = 0; r < 9; ++r) acc[r] += ldsf[r * 1024 + k] * wv[i]; }
        }
        float* red = ldsf + 9 * 1024;
        if (tid < 504) {
#pragma unroll
            for (int r = 0; r < 9; ++r) red[(kg * 9 + r) * 24 + col] = acc[r];
        }
        __syncthreads();
        if (tid < 216) { const int r = tid / 24, cc = tid % 24; float s = P.b_ada[col0 + cc];
            for (int g2 = 0; g2 < 21; ++g2) s += red[(g2 * 9 + r) * 24 + cc];
            mxf[r * 6144 + col0 + cc] = s; }
        __syncthreads();
    }
    {
        float* hT = (float*)(P.ws + WS_HT); float* hpart = (float*)(P.ws + WS_HPART);
        float* z = ldsf; float* h1 = ldsf + 32 * 33; float* h2 = h1 + 32 * 64;
        for (int it = bid; it < 256; it += G) {
            const int l0 = it * 32;
            for (int i = tid; i < 32 * 33; i += NTHR) { const int pos = i / 33, zi = i - pos * 33; const float lf = (float)(l0 + pos); float v;
                if (zi == 0) v = lf / 8191.0f;
                else { const int band = (zi - 1) & 15; const float bnd = 1e-4f + (float)band * ((15.0f - 1e-4f) / 15.0f); const float a = bnd * ((float)(6.283185307179586 / 8192.0) * lf);
                       v = zi <= 16 ? cosf(a) : -sinf(a); }
                z[i] = v; }
            __syncthreads();
            for (int i = tid; i < 2048; i += NTHR) { const int pos = i >> 6, o = i & 63; float s = P.f_b1[o];
#pragma unroll
                for (int k = 0; k < 33; ++k) s += z[pos * 33 + k] * P.f_w1[k * 64 + o];
                h1[i] = sinf(P.f_fr1[o] * s); }
            __syncthreads();
            for (int i = tid; i < 2048; i += NTHR) { const int pos = i >> 6, o = i & 63; float s = P.f_b2[o];
#pragma unroll 32
                for (int k = 0; k < 64; ++k) s += h1[pos * 64 + k] * P.f_w2[k * 64 + o];
                h2[i] = sinf(P.f_fr2[o] * s); }
            __syncthreads();
            float a0[32], a1[32];
#pragma unroll
            for (int p = 0; p < 32; ++p) { a0[p] = 0.f; a1[p] = 0.f; }
            { float wa[4], wb[4];
#pragma unroll
              for (int j = 0; j < 4; ++j) { wa[j] = P.f_w3[j * 1024 + tid]; wb[j] = P.f_w3[j * 1024 + 512 + tid]; }
#pragma unroll 1
              for (int k0 = 0; k0 < 64; k0 += 4) { float na[4], nb[4];
#pragma unroll
                for (int j = 0; j < 4; ++j) { const int kn = (k0 + 4 + j) & 63; na[j] = P.f_w3[kn * 1024 + tid]; nb[j] = P.f_w3[kn * 1024 + 512 + tid]; }
#pragma unroll
                for (int j = 0; j < 4; ++j) {
#pragma unroll
                    for (int p = 0; p < 32; ++p) { const float h = h2[p * 64 + k0 + j]; a0[p] += h * wa[j]; a1[p] += h * wb[j]; } }
#pragma unroll
                for (int j = 0; j < 4; ++j) { wa[j] = na[j]; wb[j] = nb[j]; } } }
            const float la = -3.0701134573253940f, lb = -15.350567286626970f;
            const float delta = fabsf(la + (float)tid * ((lb - la) / 511.0f));
            float asum = 0.f;
#pragma unroll
            for (int p = 0; p < 32; ++p) { const float t = (float)(l0 + p) / 8191.0f; const float dk = expf(-t * delta); a0[p] *= dk; a1[p] *= dk; asum += fabsf(a0[p]) + fabsf(a1[p]); }
#pragma unroll
            for (int p = 0; p < 32; p += 4) { *(f32x4*)(hT + (size_t)tid * SEQ + l0 + p) = (f32x4){a0[p], a0[p + 1], a0[p + 2], a0[p + 3]};
                                             *(f32x4*)(hT + (size_t)(512 + tid) * SEQ + l0 + p) = (f32x4){a1[p], a1[p + 1], a1[p + 2], a1[p + 3]}; }
            hpart[it * 512 + tid] = asum;
            __syncthreads();
        }
    }
    { float* rowss = (float*)(P.ws + WS_ROWSS); for (int i = bid * NTHR + tid; i < NTOK; i += G * NTHR) rowss[i] = 0.f; }
    {
        float* rope = (float*)(P.ws + WS_ROPE);
        for (int idx = bid * NTHR + tid; idx < SEQ * 32; idx += G * NTHR) { const int l = idx >> 5, i = idx & 31; const float pos = (float)(i < 16 ? (l >> 6) : (l & 63));
            const float inv = powf(10000.0f, -(float)(i & 15) / 16.0f); float s, c; sincosf(pos * inv, &s, &c); rope[2 * idx] = c; rope[2 * idx + 1] = s; }
    }
    {
        float* scr = (float*)(lds + wave * 16384);
        const int gw = bid * NWAVES + wave, NGW = G * NWAVES;
        constexpr int I_IN = (D / 64) * (INC / 32), I_O = (D / 64) * (D / 32), I_1 = (D / 64) * (FF / 32), I_2 = (FF / 64) * (D / 32);
        for (int it = gw; it < I_IN + I_O + I_1 + I_2; it += NGW) {
            int r = it;
            if (r < I_IN) { p0_transpose_item(P.w_in, D, INC, (bf16*)(P.ws + WS_WIN), scr, r, lane); continue; } r -= I_IN;
            if (r < I_O) { p0_transpose_item(P.w_out, D, D, (bf16*)(P.ws + WS_WOUT), scr, r, lane); continue; } r -= I_O;
            if (r < I_1) { p0_transpose_item(P.w_mlp1, D, FF, (bf16*)(P.ws + WS_W1), scr, r, lane); continue; } r -= I_1;
            p0_transpose_item(P.w_mlp2, FF, D, (bf16*)(P.ws + WS_W2), scr, r, lane);
        }
    }
}

__device__ __forceinline__ void ln_mod_row2(const float* xa, const float* xb, const float* g, const float* ma, const float* mb, int sh_off, bf16* oa, bf16* ob, int lane) {
    const f32x4* pa = (const f32x4*)xa + lane; const f32x4* pb = (const f32x4*)xb + lane;
    f32x4 va[4], vb[4]; float sa = 0.f, sb = 0.f;
#pragma unroll
    for (int j = 0; j < 4; ++j) { va[j] = __builtin_nontemporal_load(pa + 64 * j); vb[j] = __builtin_nontemporal_load(pb + 64 * j); }
#pragma unroll
    for (int j = 0; j < 4; ++j) { sa += (va[j].x * va[j].x + va[j].y * va[j].y) + (va[j].z * va[j].z + va[j].w * va[j].w); sb += (vb[j].x * vb[j].x + vb[j].y * vb[j].y) + (vb[j].z * vb[j].z + vb[j].w * vb[j].w); }
    const float ra = 1.0f / sqrtf(wave_sum(sa) * (1.0f / D) + 1e-6f), rb = 1.0f / sqrtf(wave_sum(sb) * (1.0f / D) + 1e-6f);
    v2u* qa = (v2u*)oa + lane; v2u* qb = (v2u*)ob + lane;
#pragma unroll
    for (int j = 0; j < 4; ++j) { const int col = 4 * lane + 256 * j;
        const f32x4 gg = *(const f32x4*)(g + col);
        const f32x4 ya = va[j] * ra * gg * (*(const f32x4*)(ma + sh_off + 1024 + col) + 1.0f) + *(const f32x4*)(ma + sh_off + col);
        const f32x4 yb = vb[j] * rb * gg * (*(const f32x4*)(mb + sh_off + 1024 + col) + 1.0f) + *(const f32x4*)(mb + sh_off + col);
        v2u w; w.x = pk2(ya.x, ya.y); w.y = pk2(ya.z, ya.w); qa[64 * j] = w; w.x = pk2(yb.x, yb.y); w.y = pk2(yb.z, yb.w); qb[64 * j] = w; }
}
__device__ __forceinline__ void ln_mod_row2_regs(const f32x4 (&va)[4], const f32x4 (&vb)[4], const float* g, const float* mrow, int sh_off, bf16* oa, bf16* ob, int lane) {
    float sa = 0.f, sb = 0.f;
#pragma unroll
    for (int j = 0; j < 4; ++j) { sa += (va[j].x * va[j].x + va[j].y * va[j].y) + (va[j].z * va[j].z + va[j].w * va[j].w); sb += (vb[j].x * vb[j].x + vb[j].y * vb[j].y) + (vb[j].z * vb[j].z + vb[j].w * vb[j].w); }
    const float ra = 1.0f / sqrtf(wave_sum(sa) * (1.0f / D) + 1e-6f), rb = 1.0f / sqrtf(wave_sum(sb) * (1.0f / D) + 1e-6f);
    v2u* qa = (v2u*)oa + lane; v2u* qb = (v2u*)ob + lane;
#pragma unroll
    for (int j = 0; j < 4; ++j) { const int col = 4 * lane + 256 * j;
        const f32x4 gg = *(const f32x4*)(g + col) * (*(const f32x4*)(mrow + sh_off + 1024 + col) + 1.0f), sh = *(const f32x4*)(mrow + sh_off + col);
        const f32x4 ya = va[j] * ra * gg + sh, yb = vb[j] * rb * gg + sh;
        v2u w; w.x = pk2(ya.x, ya.y); w.y = pk2(ya.z, ya.w); qa[64 * j] = w; w.x = pk2(yb.x, yb.y); w.y = pk2(yb.z, yb.w); qb[64 * j] = w; }
}
__device__ __forceinline__ void final_norm_row2(float* xa, float* xb, const float* g, int lane) {
    f32x4* pa = (f32x4*)xa + lane; f32x4* pb = (f32x4*)xb + lane;
    f32x4 va[4], vb[4]; float sa = 0.f, sb = 0.f;
#pragma unroll
    for (int j = 0; j < 4; ++j) { va[j] = pa[64 * j]; vb[j] = pb[64 * j]; }
#pragma unroll
    for (int j = 0; j < 4; ++j) { sa += (va[j].x * va[j].x + va[j].y * va[j].y) + (va[j].z * va[j].z + va[j].w * va[j].w); sb += (vb[j].x * vb[j].x + vb[j].y * vb[j].y) + (vb[j].z * vb[j].z + vb[j].w * vb[j].w); }
    const float ra = 1.0f / sqrtf(wave_sum(sa) * (1.0f / D) + 1e-6f), rb = 1.0f / sqrtf(wave_sum(sb) * (1.0f / D) + 1e-6f);
#pragma unroll
    for (int j = 0; j < 4; ++j) { const f32x4 gg = *(const f32x4*)(g + 4 * lane + 256 * j); pa[64 * j] = va[j] * ra * gg; pb[64 * j] = vb[j] * rb * gg; }
}

__device__ __forceinline__ void final_norm_row4(float* x0, const bf16* d0, const float* g, int lane) {
    f32x4 v[4][4]; v2u dl[4][4]; float s[4];
#pragma unroll
    for (int q = 0; q < 4; ++q)
#pragma unroll
        for (int j = 0; j < 4; ++j) { v[q][j] = __builtin_nontemporal_load((const f32x4*)(x0 + (size_t)q * D) + lane + 64 * j); dl[q][j] = __builtin_nontemporal_load((const v2u*)(d0 + (size_t)q * D) + lane + 64 * j); }
#pragma unroll
    for (int q = 0; q < 4; ++q) { s[q] = 0.f;
#pragma unroll
        for (int j = 0; j < 4; ++j) { v[q][j] = v[q][j] + (f32x4){bflo(dl[q][j].x), bfhi(dl[q][j].x), bflo(dl[q][j].y), bfhi(dl[q][j].y)};
            s[q] += (v[q][j].x * v[q][j].x + v[q][j].y * v[q][j].y) + (v[q][j].z * v[q][j].z + v[q][j].w * v[q][j].w); } }
#pragma unroll
    for (int o = 1; o < 64; o <<= 1) {
#pragma unroll
        for (int q = 0; q < 4; ++q) s[q] += __shfl_xor(s[q], o); }
#pragma unroll
    for (int j = 0; j < 4; ++j) { const f32x4 gg = *(const f32x4*)(g + 4 * lane + 256 * j);
#pragma unroll
        for (int q = 0; q < 4; ++q) { const float r = 1.0f / sqrtf(s[q] * (1.0f / D) + 1e-6f); __builtin_nontemporal_store(v[q][j] * r * gg, (f32x4*)(x0 + (size_t)q * D) + lane + 64 * j); } }
}

constexpr int HYW_OFF = 40960;
__device__ __forceinline__ void hy_stage_w(const Params& P, float* wl, int offA, int offB, int tid) {
    for (int i = tid; i < 8 * 512; i += NTHR) { const int r = i >> 9, c = i & 511; float v;
        if (r < 3) v = P.cw[r * 1536 + offA + c]; else if (r < 6) v = P.cw[(r - 3) * 1536 + offB + c]; else if (r == 6) v = P.cb[offA + c]; else v = P.cb[offB + c];
        wl[i] = v; }
}
struct HPreRegs { v4u dx[2][3], dv[2][3]; };
__device__ __forceinline__ void hpre_issue(HPreRegs& R, int it_, const bf16* U, int tid) {
    const int it = 4095 - it_;
    const int tl = tid >> 3, c8 = tid & 7;
    const int tt = it >> 2, cb = (it & 3) * 128, tok0 = tt * 64, l = (tok0 & (SEQ - 1)) + tl;
#pragma unroll
    for (int s = 0; s < 2; ++s)
#pragma unroll
        for (int r = 0; r < 3; ++r) { const int lr = l + r - 1; const bool ok = lr >= 0 && lr < SEQ;
            const bf16* up = U + (size_t)(tok0 + tl + (ok ? r - 1 : 0)) * INC + cb + s * 64 + c8 * 8;
            R.dx[s][r] = *(const v4u*)(up + 512); R.dv[s][r] = *(const v4u*)(up + 1024);
            if (!ok) { R.dx[s][r] = (v4u){0u, 0u, 0u, 0u}; R.dv[s][r] = (v4u){0u, 0u, 0u, 0u}; } }
}
__device__ __forceinline__ void hy_pre(const Params& P, unsigned char* lds, int tid) {
    const bf16* U = (const bf16*)(P.ws + WS_U); bf16* VXT = (bf16*)(P.ws + WS_VXT);
    bf16* T = (bf16*)lds;
    float* wl = (float*)(lds + HYW_OFF);
    hy_stage_w(P, wl, 512, 1024, tid);
    HPreRegs R;
    if ((int)blockIdx.x < 4096) hpre_issue(R, blockIdx.x, U, tid);
    __syncthreads();
    const int tl = tid >> 3, c8 = tid & 7;
    for (int it_ = blockIdx.x; it_ < 4096; it_ += gridDim.x) {
        const int it = 4095 - it_;
        const int tt = it >> 2, cb = (it & 3) * 128, tok0 = tt * 64, b = tok0 >> 13, l0 = tok0 & (SEQ - 1);
#pragma unroll
        for (int s = 0; s < 2; ++s) { const int cc = cb + s * 64 + c8 * 8;
            float ax[8], av[8];
            { const f32x4 a0 = *(const f32x4*)(wl + 6 * 512 + cc), a1 = *(const f32x4*)(wl + 6 * 512 + cc + 4), b0 = *(const f32x4*)(wl + 7 * 512 + cc), b1 = *(const f32x4*)(wl + 7 * 512 + cc + 4);
              ax[0] = a0.x; ax[1] = a0.y; ax[2] = a0.z; ax[3] = a0.w; ax[4] = a1.x; ax[5] = a1.y; ax[6] = a1.z; ax[7] = a1.w;
              av[0] = b0.x; av[1] = b0.y; av[2] = b0.z; av[3] = b0.w; av[4] = b1.x; av[5] = b1.y; av[6] = b1.z; av[7] = b1.w; }
#pragma unroll
            for (int r = 0; r < 3; ++r) { float fx[8], fv[8]; unpack8(R.dx[s][r], fx); unpack8(R.dv[s][r], fv);
                const f32x4 wa0 = *(const f32x4*)(wl + r * 512 + cc), wa1 = *(const f32x4*)(wl + r * 512 + cc + 4), wb0 = *(const f32x4*)(wl + (3 + r) * 512 + cc), wb1 = *(const f32x4*)(wl + (3 + r) * 512 + cc + 4);
                ax[0] += fx[0] * wa0.x; ax[1] += fx[1] * wa0.y; ax[2] += fx[2] * wa0.z; ax[3] += fx[3] * wa0.w; ax[4] += fx[4] * wa1.x; ax[5] += fx[5] * wa1.y; ax[6] += fx[6] * wa1.z; ax[7] += fx[7] * wa1.w;
                av[0] += fv[0] * wb0.x; av[1] += fv[1] * wb0.y; av[2] += fv[2] * wb0.z; av[3] += fv[3] * wb0.w; av[4] += fv[4] * wb1.x; av[5] += fv[5] * wb1.y; av[6] += fv[6] * wb1.z; av[7] += fv[7] * wb1.w; }
#pragma unroll
            for (int e = 0; e < 8; ++e) T[(s * 64 + c8 * 8 + e) * 72 + (tl ^ (c8 << 3))] = (bf16)f2bf(ax[e] * av[e]);
        }
        __syncthreads();
        if (it_ + (int)gridDim.x < 4096) hpre_issue(R, it_ + gridDim.x, U, tid);
#pragma unroll
        for (int q = 0; q < 2; ++q) { const int ch = q * 64 + (tid >> 3), t8 = tid & 7;
            *(v4u*)(VXT + ((size_t)(b * HYW + cb + ch)) * SEQ + l0 + t8 * 8) = *(const v4u*)(T + ch * 72 + ((t8 ^ ((ch >> 3) & 7)) << 3)); }
        __syncthreads();
    }
}
struct HPostRegs { v4u yv[4]; v4u dx[4][3]; };
__device__ __forceinline__ void hp_issue(HPostRegs& R, int it, const bf16* U, const bf16* YT, int tid) {
    const int tl = tid >> 3, c8 = tid & 7;
    const int tt = it >> 1, cb = (it & 1) * 256, tok0 = tt * 64, b = tok0 >> 13, l0 = tok0 & (SEQ - 1), l = l0 + tl;
#pragma unroll
    for (int q = 0; q < 4; ++q) { const int ch = q * 64 + (tid >> 3), t8 = tid & 7; R.yv[q] = *(const v4u*)(YT + ((size_t)(b * HYW + cb + ch)) * SEQ + l0 + t8 * 8); }
#pragma unroll
    for (int s = 0; s < 4; ++s)
#pragma unroll
        for (int r = 0; r < 3; ++r) { const int lr = l + r - 1; const bool ok = lr >= 0 && lr < SEQ;
            R.dx[s][r] = *(const v4u*)(U + (size_t)(tok0 + tl + (ok ? r - 1 : 0)) * INC + cb + s * 64 + c8 * 8);
            if (!ok) R.dx[s][r] = (v4u){0u, 0u, 0u, 0u}; }
}
__device__ __forceinline__ void hy_post(const Params& P, unsigned char* lds, int tid) {
    const bf16* U = (const bf16*)(P.ws + WS_U); const bf16* YT = (const bf16*)(P.ws + WS_YT); bf16* MIX = (bf16*)(P.ws + WS_MIX);
    bf16* T = (bf16*)lds;
    float* wl = (float*)(lds + HYW_OFF);
    hy_stage_w(P, wl, 0, 0, tid);
    HPostRegs R;
    if ((int)blockIdx.x < 2048) hp_issue(R, blockIdx.x, U, YT, tid);
    __syncthreads();
    const int tl = tid >> 3, c8 = tid & 7;
    for (int it = blockIdx.x; it < 2048; it += gridDim.x) {
        const int tt = it >> 1, cb = (it & 1) * 256, tok0 = tt * 64;
#pragma unroll
        for (int q = 0; q < 4; ++q) { const int ch = q * 64 + (tid >> 3), t8 = tid & 7; const v4u a = R.yv[q];
            T[(t8 * 8 + 0) * 264 + (ch ^ (t8 << 3))] = (bf16)(a.x & 0xffffu); T[(t8 * 8 + 1) * 264 + (ch ^ (t8 << 3))] = (bf16)(a.x >> 16);
            T[(t8 * 8 + 2) * 264 + (ch ^ (t8 << 3))] = (bf16)(a.y & 0xffffu); T[(t8 * 8 + 3) * 264 + (ch ^ (t8 << 3))] = (bf16)(a.y >> 16);
            T[(t8 * 8 + 4) * 264 + (ch ^ (t8 << 3))] = (bf16)(a.z & 0xffffu); T[(t8 * 8 + 5) * 264 + (ch ^ (t8 << 3))] = (bf16)(a.z >> 16);
            T[(t8 * 8 + 6) * 264 + (ch ^ (t8 << 3))] = (bf16)(a.w & 0xffffu); T[(t8 * 8 + 7) * 264 + (ch ^ (t8 << 3))] = (bf16)(a.w >> 16); }
        v4u dxc[4][3];
#pragma unroll
        for (int s = 0; s < 4; ++s)
#pragma unroll
            for (int r = 0; r < 3; ++r) dxc[s][r] = R.dx[s][r];
        __syncthreads();
        if (it + (int)gridDim.x < 2048) hp_issue(R, it + gridDim.x, U, YT, tid);
#pragma unroll
        for (int s = 0; s < 4; ++s) { const int cc = cb + s * 64 + c8 * 8;
            float ax[8], y[8];
            { const f32x4 a0 = *(const f32x4*)(wl + 6 * 512 + cc), a1 = *(const f32x4*)(wl + 6 * 512 + cc + 4);
              ax[0] = a0.x; ax[1] = a0.y; ax[2] = a0.z; ax[3] = a0.w; ax[4] = a1.x; ax[5] = a1.y; ax[6] = a1.z; ax[7] = a1.w; }
#pragma unroll
            for (int r = 0; r < 3; ++r) { float fx[8]; unpack8(dxc[s][r], fx);
                const f32x4 wa0 = *(const f32x4*)(wl + r * 512 + cc), wa1 = *(const f32x4*)(wl + r * 512 + cc + 4);
                ax[0] += fx[0] * wa0.x; ax[1] += fx[1] * wa0.y; ax[2] += fx[2] * wa0.z; ax[3] += fx[3] * wa0.w; ax[4] += fx[4] * wa1.x; ax[5] += fx[5] * wa1.y; ax[6] += fx[6] * wa1.z; ax[7] += fx[7] * wa1.w; }
            unpack8(*(const v4u*)(T + tl * 264 + s * 64 + ((c8 ^ (tl >> 3)) << 3)), y);
#pragma unroll
            for (int e = 0; e < 8; ++e) y[e] *= ax[e];
            *(v4u*)(MIX + (size_t)(tok0 + tl) * D + cc) = pack8(y);
        }
        __syncthreads();
    }
}

#define WAVE_LDS_FENCE() do { asm volatile("s_waitcnt lgkmcnt(0)" ::: "memory"); __builtin_amdgcn_wave_barrier(); } while (0)
__device__ __forceinline__ void hy_fft(const Params& P, unsigned char* lds, int tid, int lane, int wave) {
    cf* Z = (cf*)lds; float* scr = (float*)(lds + FFT_SCR_OFF);
    const float* hT = (const float*)(P.ws + WS_HT); const float* hpart = (const float*)(P.ws + WS_HPART);
    const unsigned short* VXT = (const unsigned short*)(P.ws + WS_VXT); unsigned short* YT = (unsigned short*)(P.ws + WS_YT);
    cf twA, twB; fft_make_tw(tid, twA, twB);
    for (int c = blockIdx.x; c < HYW; c += gridDim.x) {
        unsigned short in0[16], in1[16];
        { const unsigned short* v0 = VXT + ((size_t)(0 * HYW + c)) * SEQ + fft_opaque(tid); const unsigned short* v1 = v0 + (size_t)HYW * SEQ;
#pragma unroll
          for (int j = 0; j < 16; ++j) { in0[j] = v0[512 * j]; in1[j] = v1[512 * j]; } }
        float fv[32]; const int t_ = fft_opaque(tid);
#pragma unroll
        for (int j = 0; j < 16; ++j) fv[j] = hT[(size_t)c * SEQ + t_ + 512 * j];
#pragma unroll
        for (int j = 16; j < 32; ++j) { const int i = t_ + 512 * j; fv[j] = i == SEQ ? 0.f : hT[(size_t)(512 + c) * SEQ + (16384 - i)]; }
        const float bias = P.hy_bias[c];
        float p = tid < 256 ? hpart[tid * 512 + c] : 0.f; p = wave_sum(p);
        __syncthreads();
        if (lane == 0) scr[wave] = p;
        __syncthreads();
        float nrm = 1e-6f;
#pragma unroll
        for (int w = 0; w < NWAVES; ++w) nrm += scr[w];
        const float inv = 1.0f / nrm;
        {
#pragma unroll
          for (int j = 0; j < 32; ++j) { const int i = t_ + 512 * j; float v = fv[j] * inv; if (i == 0) v += bias; cf e; e.x = v; e.y = 0.f; Z[fphys(t_) + 528 * j] = e; } }
        __syncthreads(); fft_passA<false>(Z, tid, twA);
        __syncthreads(); fft_passB<false>(Z, tid, twB);
        WAVE_LDS_FENCE();
        cf kf0[16], kf1[16];
        fft_passC_fwd_regs(Z, tid, 0, kf0); fft_passC_fwd_regs(Z, tid, 1, kf1);
        for (int bp = 0; bp < 4; ++bp) {
            __syncthreads();
            fft_passA_fwd_in(Z, tid, twA, in0, in1);
            __syncthreads();
            fft_passB<false>(Z, tid, twB); WAVE_LDS_FENCE();
            fft_passC_mul_regs(Z, tid, 0, kf0); fft_passC_mul_regs(Z, tid, 1, kf1); WAVE_LDS_FENCE();
            fft_passB<true>(Z, tid, twB);
            if (bp < 3) { const unsigned short* v0 = VXT + ((size_t)((2 * bp + 2) * HYW + c)) * SEQ + fft_opaque(tid); const unsigned short* v1 = v0 + (size_t)HYW * SEQ;
#pragma unroll
                for (int j = 0; j < 16; ++j) { in0[j] = v0[512 * j]; in1[j] = v1[512 * j]; } }
            __syncthreads();
            unsigned short* y0 = YT + ((size_t)((2 * bp) * HYW + c)) * SEQ; unsigned short* y1 = y0 + (size_t)HYW * SEQ;
            fft_passA_inv_out(Z, tid, twA, y0, y1, 1.0f / 16384.0f, [](float a, float b_) { return pk2(a, b_); });
        }
    }
}

__device__ __forceinline__ bf16x8 lds_frag(const bf16* base, int stride, int row0, int k0, int lane) {
    return *(const bf16x8*)(base + (row0 + (lane & 15)) * stride + k0 + (lane >> 4) * 8);
}
__device__ __forceinline__ bf16x8 lds_frag_sw(const bf16* base, int row0, int k0, int lane) {
    return *(const bf16x8*)(base + (row0 + (lane & 15)) * 136 + ((k0 + (lane >> 4) * 8) ^ row0));
}
#define MFMA16(x, y, acc) __builtin_amdgcn_mfma_f32_16x16x32_bf16((x), (y), (acc), 0, 0, 0)
struct R1Regs { v4u k0, k1, v0, v1; f32x4 rp[4]; };
__device__ __forceinline__ void r1_issue(R1Regs& R, int it, const bf16* U, const bf16* UC, const float* rope, int m, int dq) {
    const int itr = 64 * 66 - 1 - it;
    const int bh = itr / 66, n = itr - bh * 66, b = bh >> 3, h = bh & 7;
    const bf16 *kp, *vp;
    if (n < 64) { const size_t row = (size_t)b * SEQ + n * 128 + m; kp = U + row * INC + 2048 + h * 64 + dq * 16; vp = kp + 512;
        const f32x4* rl = (const f32x4*)(rope + (size_t)(n * 128 + m) * 64 + dq * 16);
#pragma unroll
        for (int q = 0; q < 4; ++q) R.rp[q] = rl[q]; }
    else { const size_t row = (size_t)b * 256 + (n - 64) * 128 + m; kp = UC + row * 1024 + h * 64 + dq * 16; vp = kp + 512;
#pragma unroll
        for (int q = 0; q < 4; ++q) R.rp[q] = (f32x4){1.f, 0.f, 1.f, 0.f}; }
    R.k0 = *(const v4u*)kp; R.k1 = *(const v4u*)(kp + 8); R.v0 = *(const v4u*)vp; R.v1 = *(const v4u*)(vp + 8);
}
__device__ __forceinline__ void rope16(v4u a, v4u b, const f32x4 (&rp)[4], float scale, float (&f)[16]) {
    float x[8], y[8]; unpack8(a, x); unpack8(b, y);
#pragma unroll
    for (int e = 0; e < 8; ++e) { f[e] = x[e]; f[8 + e] = y[e]; }
#pragma unroll
    for (int q = 0; q < 4; ++q) { const f32x4 cs = rp[q];
        const float a0 = f[4 * q], b0 = f[4 * q + 1], a1 = f[4 * q + 2], b1 = f[4 * q + 3];
        f[4 * q] = (a0 * cs.x - b0 * cs.y) * scale; f[4 * q + 1] = (a0 * cs.y + b0 * cs.x) * scale; f[4 * q + 2] = (a1 * cs.z - b1 * cs.w) * scale; f[4 * q + 3] = (a1 * cs.w + b1 * cs.z) * scale; }
}
__device__ __forceinline__ void ret_r1(const Params& P, unsigned char* lds, int tid, int lane, int wave) {
    const bf16* U = (const bf16*)(P.ws + WS_U); const bf16* UC = (const bf16*)(P.ws + WS_UC); const float* rope = (const float*)(P.ws + WS_ROPE);
    bf16* T = (bf16*)(P.ws + WS_T);
    bf16* Kf = (bf16*)lds; bf16* Kb = Kf + 64 * 136; bf16* Vt = Kb + 64 * 136;
    const int m = tid >> 2, dq = tid & 3;
    R1Regs R;
    if ((int)blockIdx.x < 64 * 66) r1_issue(R, blockIdx.x, U, UC, rope, m, dq);
    float* lgt = (float*)(lds + 3 * 64 * 136 * 2);
    if (tid < 16) lgt[tid] = log_gamma_of(P.decay_logit[tid]) * 1.4426950408889634f;
    __syncthreads();
    for (int it = blockIdx.x; it < 64 * 66; it += gridDim.x) {
        const int itr = 64 * 66 - 1 - it;
        const int bh = itr / 66, n = itr - bh * 66, h = bh & 7;
        const float lgf2 = lgt[h], lgb2 = lgt[8 + h];
        const int msw = m ^ (dq << 4);
        float kk[16]; rope16(R.k0, R.k1, R.rp, 0.125f, kk);
        const float wf = fexp2(lgf2 * (float)(127 - m)), wb = fexp2(lgb2 * (float)m);
#pragma unroll
        for (int e = 0; e < 16; e += 2) { const unsigned pf_ = pk2(kk[e] * wf, kk[e + 1] * wf), pb_ = pk2(kk[e] * wb, kk[e + 1] * wb);
            Kf[(dq * 16 + e) * 136 + msw] = (bf16)(pf_ & 0xffffu); Kf[(dq * 16 + e + 1) * 136 + msw] = (bf16)(pf_ >> 16);
            Kb[(dq * 16 + e) * 136 + msw] = (bf16)(pb_ & 0xffffu); Kb[(dq * 16 + e + 1) * 136 + msw] = (bf16)(pb_ >> 16); }
        const unsigned vv[8] = {R.v0.x, R.v0.y, R.v0.z, R.v0.w, R.v1.x, R.v1.y, R.v1.z, R.v1.w};
#pragma unroll
        for (int e = 0; e < 8; ++e) { Vt[(dq * 16 + 2 * e) * 136 + msw] = (bf16)(vv[e] & 0xffffu); Vt[(dq * 16 + 2 * e + 1) * 136 + msw] = (bf16)(vv[e] >> 16); }
        __syncthreads();
        if (it + (int)gridDim.x < 64 * 66) r1_issue(R, it + gridDim.x, U, UC, rope, m, dq);
        const int dir = wave >> 2, et = wave & 3;
        const bf16* Kw = dir ? Kb : Kf;
        bf16x8 yf[4];
#pragma unroll
        for (int kc = 0; kc < 4; ++kc) yf[kc] = lds_frag_sw(Vt, et * 16, kc * 32, lane);
        bf16* Tout = T + ((size_t)(bh * 66 + n) * 2 + dir) * 4096;
#pragma unroll
        for (int dt = 0; dt < 4; ++dt) { f32x4 acc = {0.f, 0.f, 0.f, 0.f};
#pragma unroll
            for (int kc = 0; kc < 4; ++kc) acc = MFMA16(lds_frag_sw(Kw, dt * 16, kc * 32, lane), yf[kc], acc);
            v2u tw; tw.x = pk2(acc[0], acc[1]); tw.y = pk2(acc[2], acc[3]); *(v2u*)(Tout + (et * 16 + (lane & 15)) * 64 + dt * 16 + (lane >> 4) * 4) = tw; }
        __syncthreads();
    }
}
__device__ __forceinline__ f32x4 ld4bf(const bf16* p) { const v2u w = *(const v2u*)p; return (f32x4){bflo(w.x), bfhi(w.x), bflo(w.y), bfhi(w.y)}; }
__device__ __forceinline__ void ret_r2(const Params& P, int tid) {
    const bf16* T = (const bf16*)(P.ws + WS_T); bf16* S = (bf16*)(P.ws + WS_S);
    for (int idx = blockIdx.x * NTHR + tid; idx < 64 * 2 * 1024; idx += gridDim.x * NTHR) {
        const int bh = idx >> 11, dir = (idx >> 10) & 1, el = (idx & 1023) * 4, h = bh & 7;
        const float dec = expf(log_gamma_of(P.decay_logit[dir * 8 + h]) * 128.0f);
        const bf16* Tb = T + (size_t)bh * 66 * 8192 + dir * 4096 + el;
        bf16* Sb = S + (size_t)bh * 64 * 8192 + dir * 4096 + el;
        const f32x4 c0 = ld4bf(Tb + 64 * 8192), c1 = ld4bf(Tb + 65 * 8192);
        f32x4 s = dir == 0 ? c0 * dec + c1 : c0 + c1 * dec;
        if (dir == 0) {
            for (int n0 = 0; n0 < 64; n0 += 16) { v2u t[16];
#pragma unroll
                for (int u = 0; u < 16; ++u) t[u] = *(const v2u*)(Tb + (size_t)(n0 + u) * 8192);
#pragma unroll
                for (int u = 0; u < 16; ++u) { v2u w; w.x = pk2(s.x, s.y); w.y = pk2(s.z, s.w); *(v2u*)(Sb + (size_t)(n0 + u) * 8192) = w;
                    s = s * dec + (f32x4){bflo(t[u].x), bfhi(t[u].x), bflo(t[u].y), bfhi(t[u].y)}; } }
        } else {
            for (int n0 = 48; n0 >= 0; n0 -= 16) { v2u t[16];
#pragma unroll
                for (int u = 0; u < 16; ++u) t[u] = *(const v2u*)(Tb + (size_t)(n0 + u) * 8192);
#pragma unroll
                for (int u = 15; u >= 0; --u) { v2u w; w.x = pk2(s.x, s.y); w.y = pk2(s.z, s.w); *(v2u*)(Sb + (size_t)(n0 + u) * 8192) = w;
                    s = s * dec + (f32x4){bflo(t[u].x), bfhi(t[u].x), bflo(t[u].y), bfhi(t[u].y)}; } }
        }
    }
}
struct R3Regs { v4u q0, q1, k0, k1, v0, v1, sf, sb; f32x4 rp[4]; v2u g[4]; };
__device__ __forceinline__ void r3_issue(R3Regs& R, int it, const bf16* U, const bf16* S, const float* rope, const float* gn_g, int tid, int lane, int wave) {
    const int bh = it >> 6, n = it & 63, b = bh >> 3, h = bh & 7, m = tid >> 2, dq = tid & 3;
    const size_t rowbase = (size_t)b * SEQ + n * 128;
    const bf16* up = U + (rowbase + m) * INC + h * 64 + dq * 16;
    const f32x4* rl = (const f32x4*)(rope + (size_t)(n * 128 + m) * 64 + dq * 16);
    R.q0 = *(const v4u*)(up + 1536); R.q1 = *(const v4u*)(up + 1544); R.k0 = *(const v4u*)(up + 2048); R.k1 = *(const v4u*)(up + 2056); R.v0 = *(const v4u*)(up + 2560); R.v1 = *(const v4u*)(up + 2568);
#pragma unroll
    for (int q = 0; q < 4; ++q) R.rp[q] = rl[q];
    const bf16* sp = S + ((size_t)(bh * 64 + n) * 2) * 4096 + tid * 8;
    R.sf = *(const v4u*)sp; R.sb = *(const v4u*)(sp + 4096);
    const bf16* gp = U + (rowbase + wave * 16 + (lane & 15)) * INC + 3072 + h * 64 + (lane >> 4) * 4;
#pragma unroll
    for (int et = 0; et < 4; ++et) R.g[et] = *(const v2u*)(gp + et * 16);
}
__device__ __forceinline__ void ret_r3(const Params& P, unsigned char* lds, int tid, int lane, int wave) {
    const bf16* U = (const bf16*)(P.ws + WS_U); const float* rope = (const float*)(P.ws + WS_ROPE); const bf16* S = (const bf16*)(P.ws + WS_S);
    bf16* MIX = (bf16*)(P.ws + WS_MIX);
    bf16* Qs = (bf16*)lds; bf16* Ks = Qs + 128 * 72; bf16* Vt = Ks + 128 * 72; bf16* Ps = Vt + 64 * 136; bf16* Sfs = Ps + 128 * 136; bf16* Sbs = Sfs + 64 * 72;
    const int m = tid >> 2, dq = tid & 3;
    R3Regs R;
    if ((int)blockIdx.x < 64 * 64) r3_issue(R, blockIdx.x, U, S, rope, P.gn_g, tid, lane, wave);
    float* lgt = (float*)(lds + 110592);
    float* gnl = lgt + 16;
    if (tid < 16) lgt[tid] = log_gamma_of(P.decay_logit[tid]) * 1.4426950408889634f;
    gnl[tid] = P.gn_g[tid];
    __syncthreads();
    for (int it = blockIdx.x; it < 64 * 64; it += gridDim.x) {
        const int bh = it >> 6, n = it & 63, b = bh >> 3, h = bh & 7;
        const float lgf2 = lgt[h], lgb2 = lgt[8 + h];
        const size_t rowbase = (size_t)b * SEQ + n * 128;
        {
            float q[16], kk[16]; rope16(R.q0, R.q1, R.rp, 1.0f, q); rope16(R.k0, R.k1, R.rp, 0.125f, kk);
            { float t0[8], t1[8];
#pragma unroll
              for (int e = 0; e < 8; ++e) { t0[e] = q[e]; t1[e] = q[8 + e]; }
              *(v4u*)(Qs + m * 72 + dq * 16) = pack8(t0); *(v4u*)(Qs + m * 72 + dq * 16 + 8) = pack8(t1);
#pragma unroll
              for (int e = 0; e < 8; ++e) { t0[e] = kk[e]; t1[e] = kk[8 + e]; }
              *(v4u*)(Ks + m * 72 + dq * 16) = pack8(t0); *(v4u*)(Ks + m * 72 + dq * 16 + 8) = pack8(t1); }
            const unsigned vv[8] = {R.v0.x, R.v0.y, R.v0.z, R.v0.w, R.v1.x, R.v1.y, R.v1.z, R.v1.w};
            const int msw = m ^ (dq << 4);
#pragma unroll
            for (int e = 0; e < 8; ++e) { Vt[(dq * 16 + 2 * e) * 136 + msw] = (bf16)(vv[e] & 0xffffu); Vt[(dq * 16 + 2 * e + 1) * 136 + msw] = (bf16)(vv[e] >> 16); }
            const int se = (tid * 8) >> 6, sd = (tid * 8) & 63;
            *(v4u*)(Sfs + se * 72 + sd) = R.sf; *(v4u*)(Sbs + se * 72 + sd) = R.sb;
        }
        v2u gcur[4];
#pragma unroll
        for (int et = 0; et < 4; ++et) gcur[et] = R.g[et];
        __syncthreads();
        if (it + (int)gridDim.x < 64 * 64) r3_issue(R, it + gridDim.x, U, S, rope, P.gn_g, tid, lane, wave);
        const int cl = wave * 16 + (lane & 15);
        bf16x8 yq[2];
        yq[0] = lds_frag(Qs, 72, wave * 16, 0, lane); yq[1] = lds_frag(Qs, 72, wave * 16, 32, lane);
#pragma unroll
        for (int mt = 0; mt < 8; ++mt) { f32x4 acc = {0.f, 0.f, 0.f, 0.f};
            acc = MFMA16(lds_frag(Ks, 72, mt * 16, 0, lane), yq[0], acc); acc = MFMA16(lds_frag(Ks, 72, mt * 16, 32, lane), yq[1], acc);
            const int m0 = mt * 16 + (lane >> 4) * 4; float pv[4];
#pragma unroll
            for (int j = 0; j < 4; ++j) { const int diff = cl - (m0 + j); const float dv = diff > 0 ? fexp2(lgf2 * (float)diff) : (diff < 0 ? fexp2(lgb2 * (float)(-diff)) : 2.0f); pv[j] = acc[j] * dv; }
            v2u w; w.x = pk2(pv[0], pv[1]); w.y = pk2(pv[2], pv[3]); *(v2u*)(Ps + cl * 136 + m0) = w; }
        WAVE_LDS_FENCE();
        f32x4 ao[4], af[4], ab[4];
#pragma unroll
        for (int et = 0; et < 4; ++et) { ao[et] = (f32x4){0.f, 0.f, 0.f, 0.f}; af[et] = ao[et]; ab[et] = ao[et]; }
#pragma unroll
        for (int kc = 0; kc < 4; ++kc) { const bf16x8 yp = lds_frag(Ps, 136, wave * 16, kc * 32, lane);
#pragma unroll
            for (int et = 0; et < 4; ++et) ao[et] = MFMA16(lds_frag_sw(Vt, et * 16, kc * 32, lane), yp, ao[et]); }
#pragma unroll
        for (int kc = 0; kc < 2; ++kc)
#pragma unroll
            for (int et = 0; et < 4; ++et) { af[et] = MFMA16(lds_frag(Sfs, 72, et * 16, kc * 32, lane), yq[kc], af[et]); ab[et] = MFMA16(lds_frag(Sbs, 72, et * 16, kc * 32, lane), yq[kc], ab[et]); }
        const float wqf = fexp2(lgf2 * (float)(cl + 1)), wqb = fexp2(lgb2 * (float)(128 - cl));
        float s1 = 0.f;
#pragma unroll
        for (int et = 0; et < 4; ++et) { ao[et] = ao[et] + af[et] * wqf + ab[et] * wqb; s1 += (ao[et].x + ao[et].y) + (ao[et].z + ao[et].w); }
        s1 += __shfl_xor(s1, 16); s1 += __shfl_xor(s1, 32);
        const float mu = s1 * (1.0f / 64.0f); float s2 = 0.f;
#pragma unroll
        for (int et = 0; et < 4; ++et) { ao[et] = ao[et] - mu; s2 += (ao[et].x * ao[et].x + ao[et].y * ao[et].y) + (ao[et].z * ao[et].z + ao[et].w * ao[et].w); }
        s2 += __shfl_xor(s2, 16); s2 += __shfl_xor(s2, 32);
        const float rstd = 1.0f / sqrtf(s2 * (1.0f / 64.0f) + 1e-6f);
        bf16* op = MIX + (rowbase + cl) * D + 512 + h * 64;
#pragma unroll
        for (int et = 0; et < 4; ++et) { const int e0 = et * 16 + (lane >> 4) * 4;
            const v2u gw = gcur[et]; const f32x4 gn = *(const f32x4*)(gnl + h * 64 + e0);
            const float o0 = ao[et].x * rstd * gn.x * fsilu(bflo(gw.x)), o1 = ao[et].y * rstd * gn.y * fsilu(bfhi(gw.x));
            const float o2 = ao[et].z * rstd * gn.z * fsilu(bflo(gw.y)), o3 = ao[et].w * rstd * gn.w * fsilu(bfhi(gw.y));
            v2u w; w.x = pk2(o0, o1); w.y = pk2(o2, o3); *(v2u*)(op + e0) = w; }
        __syncthreads();
    }
}

#define XB_TMO      128
#define XB_XCNT(j)  (256  + 64 * (j))
#define XB_XSUB(j)  (1280 + 64 * (j))
#define XB_XGEN(j)  (2304 + 64 * (j))
#define XB_TOP      3328
#define XB_TOPGEN   3392
#define XCD_BAR_WORDS 3456
#define XB_SPIN_CAP (1u << 18)

__device__ __forceinline__ unsigned xb_ld(unsigned* p)              { return __hip_atomic_load(p, __ATOMIC_RELAXED, __HIP_MEMORY_SCOPE_AGENT); }
__device__ __forceinline__ unsigned xb_add(unsigned* p, unsigned v) { return __hip_atomic_fetch_add(p, v, __ATOMIC_RELAXED, __HIP_MEMORY_SCOPE_AGENT); }
__device__ __forceinline__ unsigned xb_xcc_id() { return (unsigned)__builtin_amdgcn_s_getreg((3 << 11) | 20) & 0xFu; }
#define XB_SPIN(cond, bar) do { unsigned _sp = 0; while (cond) { __builtin_amdgcn_s_sleep(1); \
    if ((++_sp & 255u) == 0u) { if (xb_ld(&(bar)[XB_TMO])) break; if (_sp > XB_SPIN_CAP) { atomicAdd(&(bar)[XB_TMO], 1u); break; } } } } while (0)

struct XcdBarrier {
    unsigned* bar; unsigned x;
    volatile LAS unsigned* st;
};

__device__ __forceinline__ XcdBarrier xcd_barrier_post(unsigned* bar, volatile LAS unsigned* st) {
    XcdBarrier b; b.bar = bar; b.x = xb_xcc_id(); b.st = st;
    if (threadIdx.x == 0) (void)xb_add(&bar[XB_XCNT(b.x)], 1u);
    return b;
}
__device__ __forceinline__ void xcd_barrier_complete(unsigned* bar, unsigned x, unsigned& nloc, unsigned& nx) {
    const unsigned G = gridDim.x * gridDim.y * gridDim.z;
    unsigned sum, cnt, mine, sp = 0u;
    for (;;) {
        sum = 0u; cnt = 0u; mine = 0u;
#pragma unroll
        for (unsigned j = 0; j < 16; ++j) { const unsigned c = xb_ld(&bar[XB_XCNT(j)]); sum += c; cnt += (c > 0u) ? 1u : 0u; mine = (j == x) ? c : mine; }
        if (sum == G) break;
        __builtin_amdgcn_s_sleep(1);
        if ((++sp & 255u) == 0u) { if (xb_ld(&bar[XB_TMO])) break; if (sp > XB_SPIN_CAP) { atomicAdd(&bar[XB_TMO], 1u); break; } }
    }
    nloc = mine > 0u ? mine : 1u; nx = cnt > 0u ? cnt : 1u;
}

__device__ __forceinline__ void xcd_barrier(const XcdBarrier& b) {
    asm volatile("s_waitcnt vmcnt(0)" ::: "memory");
    __syncthreads();
    if (threadIdx.x == 0) {
        unsigned* bar = b.bar;
        __builtin_amdgcn_s_waitcnt(0);
        unsigned nloc = b.st[0], nx = b.st[1];
        if (nloc == 0u) { xcd_barrier_complete(bar, b.x, nloc, nx); b.st[0] = nloc; b.st[1] = nx; }
        const unsigned old = xb_add(&bar[XB_XSUB(b.x)], 1u);
        const unsigned gen = old / nloc;
        if (old + 1u == (gen + 1u) * nloc) {
            __builtin_amdgcn_fence(__ATOMIC_RELEASE, "agent");
            asm volatile("s_waitcnt vmcnt(0)" ::: "memory");
            const unsigned og = xb_add(&bar[XB_TOP], 1u);
            const unsigned tg = og / nx;
            if (og + 1u == (tg + 1u) * nx) xb_add(&bar[XB_TOPGEN], 1u);
            else XB_SPIN(xb_ld(&bar[XB_TOPGEN]) == tg, bar);
            __builtin_amdgcn_fence(__ATOMIC_ACQUIRE, "agent");
            xb_add(&bar[XB_XGEN(b.x)], 1u);
            asm volatile("s_waitcnt vmcnt(0)" ::: "memory");
        } else {
            XB_SPIN(xb_ld(&bar[XB_XGEN(b.x)]) == gen, bar);
            __builtin_amdgcn_fence(__ATOMIC_ACQUIRE, "agent");
            asm volatile("s_waitcnt vmcnt(0)" ::: "memory");
        }
    }
    __syncthreads();
}

__global__ void __launch_bounds__(NTHR, 2) hymba_fwd(Params P) {
    extern __shared__ __attribute__((aligned(16))) unsigned char lds[];
    const int tid = threadIdx.x, lane = tid & 63, wave = __builtin_amdgcn_readfirstlane(tid >> 6);
    const int G = gridDim.x, bid = blockIdx.x;
    const int lo = P.ph_lo, hi = P.ph_hi;
    unsigned char* ws = P.ws;
    const float* mxf = (const float*)(ws + WS_MXF);
#ifndef REP_MASK
#define REP_MASK 0
#endif
#ifndef EXTRA_SYNCS
#define EXTRA_SYNCS 0
#endif
#ifndef PH_MASK
#define PH_MASK 0x7ff
#endif
#define IN(k) (((PH_MASK >> (k)) & 1) && lo <= (k) && (k) < hi)
    if (tid < 16) ((volatile LAS unsigned*)((LAS unsigned char*)lds + LDS_BARST_OFF))[tid] = 0u;
    __syncthreads();
    const XcdBarrier bar = xcd_barrier_post((unsigned*)(ws + WS_CTL), (volatile LAS unsigned*)((LAS unsigned char*)lds + LDS_BARST_OFF));
    if (lo < 0) cg::this_grid().sync();
#define SEAM(k) do { if (IN(k) && IN((k) + 1)) xcd_barrier(bar); } while (0)
    const int gw = bid * NWAVES + wave, NGW = G * NWAVES;
    if (IN(0)) { phase0(P, lds, tid, lane, wave); if ((REP_MASK >> 0) & 1) { __syncthreads(); phase0(P, lds, tid, lane, wave); } }
    SEAM(0);
    constexpr int NCB = (NCTX / 256) * (1024 / 256);
    const bool ctx_in_p1 = G >= 2 * NCB;
    if (IN(1)) {
        bf16* HX = (bf16*)(ws + WS_HX);
        const float* m8 = mxf + (size_t)8 * 6144;
        if (ctx_in_p1 && bid < NCB) {
            pg8::StaticOrder S; S.init(NCTX, 1024, NCB, bid); pg8::Unit u0; S.next(0, u0);
            for (int i = 0; i < 32; i += 2) { const int r = u0.pm * 256 + wave * 32 + i;
                ln_mod_row2(P.ctx + (size_t)r * D, P.ctx + (size_t)(r + 1) * D, P.norm1_g, m8, m8, 0, HX + (size_t)(NTOK + r) * D, HX + (size_t)(NTOK + r + 1) * D, lane); }
            asm volatile("s_waitcnt vmcnt(0)" ::: "memory"); __syncthreads();
            pg8::Gemm g{(const pg8::bf16_t*)(ws + WS_HX) + (size_t)NTOK * D, (const pg8::bf16_t*)(ws + WS_WIN) + (size_t)2048 * D, NCTX, 1024, D};
            pg8::EpiBf16<0> E{(pg8::bf16_t*)(ws + WS_UC), 1024, nullptr, 0, 0, 1.f, nullptr, 0};
            pg8::gemm_phase<pg8::EpiBf16<0>, pg8::StaticOrder, true, true>((LAS unsigned char*)lds, g, S, E);
            __syncthreads();
        } else {
            const int wgw = (ctx_in_p1 ? bid - NCB : bid) * NWAVES + wave, WNGW = (ctx_in_p1 ? G - NCB : G) * NWAVES, nrows = ctx_in_p1 ? NTOK : NTOK + NCTX;
            f32x4 pa[4], pb[4];
            { const int r = 2 * wgw; if (r < nrows) { const float* xa = r < NTOK ? P.x + (size_t)r * D : P.ctx + (size_t)(r - NTOK) * D;
#pragma unroll
                for (int j = 0; j < 4; ++j) { pa[j] = __builtin_nontemporal_load((const f32x4*)xa + lane + 64 * j); pb[j] = __builtin_nontemporal_load((const f32x4*)(xa + D) + lane + 64 * j); } } }
            for (int r = 2 * wgw; r < nrows; r += 2 * WNGW) {
                f32x4 ca[4], cb2[4];
#pragma unroll
                for (int j = 0; j < 4; ++j) { ca[j] = pa[j]; cb2[j] = pb[j]; }
                const int rn = r + 2 * WNGW;
                if (rn < nrows) { const float* xn = rn < NTOK ? P.x + (size_t)rn * D : P.ctx + (size_t)(rn - NTOK) * D;
#pragma unroll
                    for (int j = 0; j < 4; ++j) { pa[j] = __builtin_nontemporal_load((const f32x4*)xn + lane + 64 * j); pb[j] = __builtin_nontemporal_load((const f32x4*)(xn + D) + lane + 64 * j); } }
                const float* m_ = mxf + (size_t)(r < NTOK ? (r >> 13) : 8) * 6144;
                ln_mod_row2_regs(ca, cb2, P.norm1_g, m_, 0, HX + (size_t)r * D, HX + (size_t)(r + 1) * D, lane);
            }
        }
    }
    if (IN(1)) {
        float* gm = (float*)(ws + WS_GM); float* sbt = (float*)(ws + WS_SB); const bf16* W1T = (const bf16*)(ws + WS_W1);
        for (int i = bid * NTHR + tid; i < 8 * 1024; i += G * NTHR) { const int b_ = i >> 10, c_ = i & 1023; gm[i] = P.norm2_g[c_] * (1.0f + mxf[(size_t)b_ * 6144 + 4 * 1024 + c_]); }
        for (int n = gw; n < FF; n += NGW) {
            float w[16]; { float t0[8], t1[8]; unpack8(*(const v4u*)(W1T + (size_t)n * D + lane * 16), t0); unpack8(*(const v4u*)(W1T + (size_t)n * D + lane * 16 + 8), t1);
#pragma unroll
                for (int e = 0; e < 8; ++e) { w[e] = t0[e]; w[8 + e] = t1[e]; } }
#pragma unroll
            for (int b_ = 0; b_ < 8; ++b_) { const float* sh = mxf + (size_t)b_ * 6144 + 3 * 1024 + lane * 16; float s = 0.f;
#pragma unroll
                for (int q = 0; q < 4; ++q) { const f32x4 v = *(const f32x4*)(sh + 4 * q); s += (v.x * w[4 * q] + v.y * w[4 * q + 1]) + (v.z * w[4 * q + 2] + v.w * w[4 * q + 3]); }
                s = wave_sum(s); if (lane == 0) sbt[b_ * FF + n] = s; }
        }
    }
    SEAM(1);
    if (IN(2)) {
        { pg8::Gemm g{(const pg8::bf16_t*)(ws + WS_HX), (const pg8::bf16_t*)(ws + WS_WIN), NTOK, INC, D}; pg8::StaticOrder S; S.init(NTOK, INC, G, bid);
          pg8::EpiBf16<0> E{(pg8::bf16_t*)(ws + WS_U), INC, nullptr, 0, 0, 1.f, nullptr, 0};
          pg8::gemm_phase<pg8::EpiBf16<0>, pg8::StaticOrder, true, true>((LAS unsigned char*)lds, g, S, E); }
        __syncthreads();
        if (!ctx_in_p1) { pg8::Gemm g{(const pg8::bf16_t*)(ws + WS_HX) + (size_t)NTOK * D, (const pg8::bf16_t*)(ws + WS_WIN) + (size_t)2048 * D, NCTX, 1024, D}; pg8::StaticOrder S; S.init(NCTX, 1024, G, bid);
          pg8::EpiBf16<0> E{(pg8::bf16_t*)(ws + WS_UC), 1024, nullptr, 0, 0, 1.f, nullptr, 0};
          pg8::gemm_phase<pg8::EpiBf16<0>, pg8::StaticOrder, true, true>((LAS unsigned char*)lds, g, S, E); }
        __syncthreads();
    }
    SEAM(2);
    for (int rep = 0; rep < 1 + ((REP_MASK >> 3) & 1); ++rep)
    if (IN(3)) { hy_pre(P, lds, tid); if ((REP_MASK >> 15) & 1) hy_pre(P, lds, tid); ret_r1(P, lds, tid, lane, wave); if ((REP_MASK >> 13) & 1) ret_r1(P, lds, tid, lane, wave); }
    SEAM(3);
    for (int rep = 0; rep < 1 + ((REP_MASK >> 4) & 1); ++rep)
    if (IN(4)) { hy_fft(P, lds, tid, lane, wave); if ((REP_MASK >> 11) & 1) hy_fft(P, lds, tid, lane, wave); ret_r2(P, tid); if ((REP_MASK >> 12) & 1) ret_r2(P, tid); }
    SEAM(4);
    for (int rep = 0; rep < 1 + ((REP_MASK >> 5) & 1); ++rep)
    if (IN(5)) { hy_post(P, lds, tid); if ((REP_MASK >> 16) & 1) hy_post(P, lds, tid); ret_r3(P, lds, tid, lane, wave); if ((REP_MASK >> 14) & 1) ret_r3(P, lds, tid, lane, wave); }
    SEAM(5);
    if (IN(6)) {
        pg8::Gemm g{(const pg8::bf16_t*)(ws + WS_MIX), (const pg8::bf16_t*)(ws + WS_WOUT), NTOK, D, D}; pg8::StaticOrder S; S.init(NTOK, D, G, bid);
        pg8::EpiResF32Ln E{P.x, P.out, mxf + 2 * 1024, D, (const float*)(ws + WS_GM), (pg8::bf16_t*)(ws + WS_HX), (float*)(ws + WS_ROWSS)};
        pg8::gemm_phase<pg8::EpiResF32Ln, pg8::StaticOrder, true, true>((LAS unsigned char*)lds, g, S, E);
        __syncthreads();
    }
    if (IN(6) && IN(8)) xcd_barrier(bar);
    if (IN(8)) {
        pg8::Gemm g{(const pg8::bf16_t*)(ws + WS_HX), (const pg8::bf16_t*)(ws + WS_W1), NTOK, FF, D}; pg8::StaticOrder S; S.init(NTOK, FF, G, bid);
        pg8::EpiBf16<2> E{(pg8::bf16_t*)(ws + WS_HID), FF, (const float*)(ws + WS_SB), 0, 0, 1.f, (const float*)(ws + WS_ROWSS), FF};
        pg8::gemm_phase<pg8::EpiBf16<2>, pg8::StaticOrder, true, true>((LAS unsigned char*)lds, g, S, E);
        __syncthreads();
    }
    SEAM(8);
    if (IN(9)) {
        pg8::Gemm g{(const pg8::bf16_t*)(ws + WS_HID), (const pg8::bf16_t*)(ws + WS_W2), NTOK, D, FF}; pg8::RevStaticOrder S; S.init(NTOK, D, G, bid);
        pg8::EpiGateBf16 E{(pg8::bf16_t*)(ws + WS_MIX), D, mxf + 5 * 1024};
        pg8::gemm_phase<pg8::EpiGateBf16, pg8::RevStaticOrder, true, true>((LAS unsigned char*)lds, g, S, E);
        __syncthreads();
    }
    SEAM(9);
    for (int es = 0; es < EXTRA_SYNCS; ++es) xcd_barrier(bar);
    if (IN(10)) { for (int r = 4 * gw; r < NTOK; r += 4 * NGW) final_norm_row4(P.out + (size_t)r * D, (const bf16*)(ws + WS_MIX) + (size_t)r * D, P.norm_f_g, lane); }
#undef IN
#undef SEAM
}

extern "C" void kernel_launch(void* const* d_in, const int* in_sizes, int n_in, void* d_out, int out_size, void* d_ws, size_t ws_size, hipStream_t stream) {
    static int grid = 0;
    if (grid == 0) {
        if (n_in != 25 || in_sizes[0] != NTOK * D || out_size != NTOK * D || ws_size < WS_END) { fprintf(stderr, "kernel_launch: unexpected shapes (n_in %d, in0 %d, out %d, ws %zu; need ws >= %zu)\n", n_in, n_in > 0 ? in_sizes[0] : -1, out_size, ws_size, (size_t)WS_END); grid = -1; return; }
        int dev = 0, cus = 0, per_cu = 0;
        if (hipGetDevice(&dev) != hipSuccess || hipDeviceGetAttribute(&cus, hipDeviceAttributeMultiprocessorCount, dev) != hipSuccess) { grid = -1; return; }
        if (hipFuncSetAttribute((const void*)hymba_fwd, hipFuncAttributeMaxDynamicSharedMemorySize, LDS_BYTES) != hipSuccess) { fprintf(stderr, "kernel_launch: hipFuncSetAttribute failed\n"); grid = -1; return; }
        if (hipOccupancyMaxActiveBlocksPerMultiprocessor(&per_cu, (const void*)hymba_fwd, NTHR, LDS_BYTES) != hipSuccess || per_cu < 1) { fprintf(stderr, "kernel_launch: occupancy query says %d blocks/CU\n", per_cu); (void)hipGetLastError(); grid = -1; return; }
        grid = cus * 1;
    }
    if (grid < 0) return;
    Params p{};
    const float** pp = (const float**)&p;
    for (int i = 0; i < 25; ++i) pp[i] = (const float*)d_in[i];
    p.out = (float*)d_out; p.ws = (unsigned char*)d_ws;
    p.ph_lo = 0; p.ph_hi = NPHASE;
    if (hipMemsetAsync((char*)d_ws + WS_CTL, 0, CTL_BYTES, stream) != hipSuccess) { fprintf(stderr, "kernel_launch: memset of the barrier words failed\n"); return; }
    void* args[] = {&p};
    hipError_t e = hipLaunchCooperativeKernel((const void*)hymba_fwd, dim3(grid), dim3(NTHR), args, LDS_BYTES, stream);
    if (e != hipSuccess) fprintf(stderr, "cooperative launch failed: %s (grid %d)\n", hipGetErrorString(e), grid);
}
```

```cpp
#include <hip/hip_runtime.h>
#include <cstdio>
#include <cstdint>
#include <cmath>
namespace pg8 {
#define PG8_LAS __attribute__((address_space(3)))
typedef unsigned short bf16_t;
typedef short bf16x8 __attribute__((ext_vector_type(8)));
typedef float f32x4 __attribute__((ext_vector_type(4)));
typedef unsigned u32x4 __attribute__((ext_vector_type(4)));
constexpr int BM = 256, BK = 64, HALF = 128, HTB = HALF * BK * 2  , STAGE_BYTES = 8 * HTB, NXCD = 8, WGM = 8;

__host__ __device__ __forceinline__ int lds_byte(int r, int c) { const int st = (r >> 4) * 2 + (c >> 5), rr = r & 15, cc = c & 31, ob = rr * 64 + cc * 2; return st * 1024 + (ob ^ (((ob >> 9) & 1) << 5)); }
__host__ __device__ __forceinline__ void stage_rc(int b, int& R, int& C) { const int st = b / 1024, sb = b % 1024, swz = sb ^ (((sb >> 9) & 1) << 5); R = (st >> 1) * 16 + swz / 64; C = (st & 1) * 32 + (swz % 64) / 2; }
__host__ __device__ __forceinline__ int perm32(int rho) { const int n = rho >> 4, i = rho & 15; return 8 * (i >> 2) + 4 * n + (i & 3); }

struct Unit { int pm, pn; };
struct Gemm { const bf16_t* A; const bf16_t* Bt; int M, N, K; };

struct StaticOrder {
    int nM, nN, nwg, G, c;
    __host__ __device__ void init(int M, int N, int G_, int c_) { nM = M / BM; nN = N / BM; nwg = nM * nN; G = G_; c = c_; }
    __host__ __device__ bool next(int i, Unit& u) const {
        const long L = (long)i * G + c; if (L >= nwg) return false;
        int wgid = (int)L; { const int q = nwg / NXCD, r = nwg % NXCD, xcd = wgid % NXCD, off = wgid / NXCD; wgid = (xcd < r ? xcd * (q + 1) : r * (q + 1) + (xcd - r) * q) + off; }
        const int nig = WGM * nN, gid = wgid / nig, fm = gid * WGM, gsz = (nM - fm) < WGM ? (nM - fm) : WGM;
        u.pm = fm + ((wgid % nig) % gsz); u.pn = (wgid % nig) / gsz; return true;
    }
    __device__ __forceinline__ void a_ready(const Unit&) const {}
    __device__ __forceinline__ void done(const Unit&) const {}
};

__device__ __forceinline__ unsigned cvt_pk_bf16(float lo, float hi) { unsigned r; asm volatile("v_cvt_pk_bf16_f32 %0, %1, %2" : "=v"(r) : "v"(lo), "v"(hi)); return r; }
typedef float f32x2 __attribute__((ext_vector_type(2)));
__device__ __forceinline__ f32x2 gelu_pk(f32x2 v) {
    const f32x2 av = __builtin_elementwise_abs(v), d = av * 0.2316418882f + 1.0f;
    f32x2 t; t.x = __builtin_amdgcn_rcpf(d.x); t.y = __builtin_amdgcn_rcpf(d.y);
    f32x2 q = t * 0.5307027145f + (-0.7265760135f); q = q * t + 0.7107068705f; q = q * t + (-0.142248368f); q = q * t + 0.127414796f; q = q * t;
    const f32x2 s = (v * v) * (-0.72134752044f);
    f32x2 e; e.x = __builtin_amdgcn_exp2f(s.x); e.y = __builtin_amdgcn_exp2f(s.y);
    const f32x2 m = v * (q * e), r = v - m;
    f32x2 o; o.x = v.x < 0.f ? m.x : r.x; o.y = v.y < 0.f ? m.y : r.y; return o;
}

template <int ACT  > struct EpiBf16 {
    static constexpr bool PERM = true, AFTER_DRAIN = false; static_assert(ACT == 0 || ACT == 1 || ACT == 2, "EpiBf16: ACT is 0 (none), 1 (gelu_pk) or 2 (squared relu)");
    bf16_t* O; int ldc; const float* bias; int split_cols; size_t split_stride; float scale0; const float* rowss; int bias_bstride;
    __device__ __forceinline__ void operator()(const f32x4 (&acc)[2][2][4][2], const Unit& u, int wr, int wc, int fr, int fq) const {
        const int row0 = u.pm * BM + wr * 64 + fr; int colt = u.pn * BM; bf16_t* base = O;
        float sc = 1.f; if (split_cols) { const int t = colt / split_cols; base += (size_t)t * split_stride; colt -= t * split_cols; if (t == 0) sc = scale0; }
        const int col0 = colt + wc * 32 + 8 * fq, bcol0 = u.pn * BM + wc * 32 + 8 * fq;
        f32x4 bv[2][2];
#pragma unroll
        for (int bj = 0; bj < 2; ++bj)
#pragma unroll
            for (int n = 0; n < 2; ++n) bv[bj][n] = bias ? *(const f32x4*)(bias + (size_t)(u.pm >> 5) * bias_bstride + bcol0 + bj * HALF + 4 * n) : (f32x4){0.f, 0.f, 0.f, 0.f};
#pragma unroll
        for (int ai = 0; ai < 2; ++ai)
#pragma unroll
            for (int m = 0; m < 4; ++m) { bf16_t* rowp = base + (size_t)(row0 + ai * HALF + m * 16) * ldc + col0; const float rs = rowss ? 1.0f / sqrtf(rowss[row0 + ai * HALF + m * 16] * (1.0f / 1024.0f) + 1e-6f) : 1.0f;
#pragma unroll
                for (int bj = 0; bj < 2; ++bj) { f32x4 v0 = acc[ai][bj][m][0] * rs + bv[bj][0], v1 = acc[ai][bj][m][1] * rs + bv[bj][1];
                    if (ACT == 1) { f32x2 a = gelu_pk((f32x2){v0[0], v0[1]}), b = gelu_pk((f32x2){v0[2], v0[3]}), c = gelu_pk((f32x2){v1[0], v1[1]}), d = gelu_pk((f32x2){v1[2], v1[3]});
                        v0 = (f32x4){a.x, a.y, b.x, b.y}; v1 = (f32x4){c.x, c.y, d.x, d.y}; }
                    if (ACT == 2) { v0 = __builtin_elementwise_max(v0, (f32x4){0.f, 0.f, 0.f, 0.f}); v1 = __builtin_elementwise_max(v1, (f32x4){0.f, 0.f, 0.f, 0.f}); v0 = v0 * v0; v1 = v1 * v1; }
                    v0 = v0 * sc; v1 = v1 * sc; u32x4 w; w.x = cvt_pk_bf16(v0[0], v0[1]); w.y = cvt_pk_bf16(v0[2], v0[3]); w.z = cvt_pk_bf16(v1[0], v1[1]); w.w = cvt_pk_bf16(v1[2], v1[3]);
                    *(u32x4*)(rowp + bj * HALF) = w; } }
    }
};
struct EpiResF32 {
    static constexpr bool PERM = false, AFTER_DRAIN = false;
    const float* base; float* out; const float* gate; int ldc;
    __device__ __forceinline__ void operator()(const f32x4 (&acc)[2][2][4][2], const Unit& u, int wr, int wc, int fr, int fq) const {
        const float* g = gate + (size_t)(u.pm >> 5) * 6144;
        const int col0 = u.pn * BM + wc * 32 + 4 * fq;
        f32x4 gv[2][2];
#pragma unroll
        for (int bj = 0; bj < 2; ++bj)
#pragma unroll
            for (int n = 0; n < 2; ++n) gv[bj][n] = *(const f32x4*)(g + col0 + bj * HALF + n * 16);
#pragma unroll
        for (int ai = 0; ai < 2; ++ai) {
            f32x4 bs[4][2][2];
#pragma unroll
            for (int m = 0; m < 4; ++m) { const size_t off = (size_t)(u.pm * BM + ai * HALF + wr * 64 + m * 16 + fr) * ldc + col0;
#pragma unroll
                for (int bj = 0; bj < 2; ++bj)
#pragma unroll
                    for (int n = 0; n < 2; ++n) bs[m][bj][n] = *(const f32x4*)(base + off + bj * HALF + n * 16); }
#pragma unroll
            for (int m = 0; m < 4; ++m) { const size_t off = (size_t)(u.pm * BM + ai * HALF + wr * 64 + m * 16 + fr) * ldc + col0;
#pragma unroll
                for (int bj = 0; bj < 2; ++bj)
#pragma unroll
                    for (int n = 0; n < 2; ++n) *(f32x4*)(out + off + bj * HALF + n * 16) = bs[m][bj][n] + gv[bj][n] * acc[ai][bj][m][n]; }
            asm volatile("" ::: "memory"); }
    }
};

struct EpiResF32Ln {
    static constexpr bool PERM = false, AFTER_DRAIN = false;
    const float* base; float* out; const float* gate; int ldc; const float* gm; bf16_t* xg; float* rowss;
    __device__ __forceinline__ void operator()(const f32x4 (&acc)[2][2][4][2], const Unit& u, int wr, int wc, int fr, int fq) const {
        typedef unsigned u32x2v __attribute__((ext_vector_type(2)));
        const float* g = gate + (size_t)(u.pm >> 5) * 6144; const float* gmb = gm + (size_t)(u.pm >> 5) * 1024;
        const int col0 = u.pn * BM + wc * 32 + 4 * fq;
        f32x4 gv[2][2], mv[2][2];
#pragma unroll
        for (int bj = 0; bj < 2; ++bj)
#pragma unroll
            for (int n = 0; n < 2; ++n) { gv[bj][n] = *(const f32x4*)(g + col0 + bj * HALF + n * 16); mv[bj][n] = *(const f32x4*)(gmb + col0 + bj * HALF + n * 16); }
#pragma unroll
        for (int ai = 0; ai < 2; ++ai)
#pragma unroll
            for (int mp = 0; mp < 4; mp += 2) {
                f32x4 bsv[2][2][2];
#pragma unroll
                for (int mm = 0; mm < 2; ++mm) { const size_t off = (size_t)(u.pm * BM + ai * HALF + wr * 64 + (mp + mm) * 16 + fr) * ldc + col0;
#pragma unroll
                    for (int bj = 0; bj < 2; ++bj)
#pragma unroll
                        for (int n = 0; n < 2; ++n) bsv[mm][bj][n] = *(const f32x4*)(base + off + bj * HALF + n * 16); }
#pragma unroll
                for (int mm = 0; mm < 2; ++mm) { const int m = mp + mm; const int row = u.pm * BM + ai * HALF + wr * 64 + m * 16 + fr; const size_t off = (size_t)row * ldc + col0; float ss = 0.f;
#pragma unroll
                    for (int bj = 0; bj < 2; ++bj)
#pragma unroll
                        for (int n = 0; n < 2; ++n) { const f32x4 o = bsv[mm][bj][n] + gv[bj][n] * acc[ai][bj][m][n];
                            *(f32x4*)(out + off + bj * HALF + n * 16) = o;
                            ss += (o.x * o.x + o.y * o.y) + (o.z * o.z + o.w * o.w);
                            const f32x4 y = o * mv[bj][n]; u32x2v w; w.x = cvt_pk_bf16(y.x, y.y); w.y = cvt_pk_bf16(y.z, y.w);
                            *(u32x2v*)(xg + off + bj * HALF + n * 16) = w; }
                    ss += __shfl_xor(ss, 16); ss += __shfl_xor(ss, 32);
                    if (fq == 0) atomicAdd(rowss + row, ss); }
                asm volatile("" ::: "memory"); }
    }
};

struct PanelOrder {
    int G, c, nM;
    __host__ __device__ void init(int M, int G_, int c_) { nM = M / BM; G = G_; c = c_; }
    __host__ __device__ bool next(int i, Unit& u) const { const int pm = c + (i >> 2) * G; if (pm >= nM) return false; u.pm = pm; u.pn = i & 3; return true; }
    __device__ __forceinline__ void a_ready(const Unit&) const {}
    __device__ __forceinline__ void done(const Unit&) const {}
};
struct EpiResF32Fin {
    static constexpr bool PERM = false, AFTER_DRAIN = false;
    const float* base; float* out; const float* gate; int ldc; const float* gf; PG8_LAS float* rs;
    __device__ __forceinline__ void operator()(const f32x4 (&acc)[2][2][4][2], const Unit& u, int wr, int wc, int fr, int fq) const {
        const float* g = gate + (size_t)(u.pm >> 5) * 6144;
        const int col0 = u.pn * BM + wc * 32 + 4 * fq;
        f32x4 gv[2][2];
#pragma unroll
        for (int bj = 0; bj < 2; ++bj)
#pragma unroll
            for (int n = 0; n < 2; ++n) gv[bj][n] = *(const f32x4*)(g + col0 + bj * HALF + n * 16);
#pragma unroll
        for (int ai = 0; ai < 2; ++ai)
#pragma unroll
            for (int m = 0; m < 4; ++m) { const int rl = ai * HALF + wr * 64 + m * 16 + fr; const size_t off = (size_t)(u.pm * BM + rl) * ldc + col0; float ss = 0.f;
#pragma unroll
                for (int bj = 0; bj < 2; ++bj)
#pragma unroll
                    for (int n = 0; n < 2; ++n) { const f32x4 bs = *(const f32x4*)(base + off + bj * HALF + n * 16);
                        const f32x4 o = bs + gv[bj][n] * acc[ai][bj][m][n];
                        *(f32x4*)(out + off + bj * HALF + n * 16) = o;
                        ss += (o.x * o.x + o.y * o.y) + (o.z * o.z + o.w * o.w); }
                ss += __shfl_xor(ss, 16); ss += __shfl_xor(ss, 32);
                if (fq == 0) __hip_atomic_fetch_add((float*)(rs + rl), ss, __ATOMIC_RELAXED, __HIP_MEMORY_SCOPE_WORKGROUP);
                if (m & 1) asm volatile("" ::: "memory"); }
        if (u.pn == 3) {
            asm volatile("s_waitcnt vmcnt(0) lgkmcnt(0)" ::: "memory"); __builtin_amdgcn_s_barrier(); asm volatile("" ::: "memory");
            const int lane = fr + 16 * fq, wid = wr * 4 + wc;
            for (int i = 0; i < 32; i += 2) { const int r0 = wid * 32 + i;
                f32x4* pa = (f32x4*)(out + (size_t)(u.pm * BM + r0) * ldc) + lane; f32x4* pb = pa + ldc / 4;
                f32x4 va[4], vb[4];
#pragma unroll
                for (int j = 0; j < 4; ++j) { va[j] = pa[64 * j]; vb[j] = pb[64 * j]; }
                const float ra = 1.0f / sqrtf(rs[r0] * (1.0f / 1024.0f) + 1e-6f), rb = 1.0f / sqrtf(rs[r0 + 1] * (1.0f / 1024.0f) + 1e-6f);
#pragma unroll
                for (int j = 0; j < 4; ++j) { const f32x4 gg = *(const f32x4*)(gf + 4 * lane + 256 * j); pa[64 * j] = va[j] * ra * gg; pb[64 * j] = vb[j] * rb * gg; } }
            asm volatile("s_waitcnt lgkmcnt(0)" ::: "memory"); __builtin_amdgcn_s_barrier(); asm volatile("" ::: "memory");
            if (wid * 64 + lane < 256) rs[wid * 64 + lane] = 0.f;
            asm volatile("s_waitcnt lgkmcnt(0)" ::: "memory"); __builtin_amdgcn_s_barrier(); asm volatile("" ::: "memory");
        }
    }
};

struct RevStaticOrder {
    StaticOrder S;
    __host__ __device__ void init(int M, int N, int G_, int c_) { S.init(M, N, G_, c_); }
    __host__ __device__ bool next(int i, Unit& u) const { if (!S.next(i, u)) return false; u.pm = S.nM - 1 - u.pm; return true; }
    __device__ __forceinline__ void a_ready(const Unit&) const {}
    __device__ __forceinline__ void done(const Unit&) const {}
};

struct EpiGateBf16 {
    static constexpr bool PERM = true, AFTER_DRAIN = false;
    bf16_t* O; int ldc; const float* gate;
    __device__ __forceinline__ void operator()(const f32x4 (&acc)[2][2][4][2], const Unit& u, int wr, int wc, int fr, int fq) const {
        const int row0 = u.pm * BM + wr * 64 + fr, col0 = u.pn * BM + wc * 32 + 8 * fq;
        const float* g = gate + (size_t)(u.pm >> 5) * 6144;
        f32x4 gv[2][2];
#pragma unroll
        for (int bj = 0; bj < 2; ++bj)
#pragma unroll
            for (int n = 0; n < 2; ++n) gv[bj][n] = *(const f32x4*)(g + col0 + bj * HALF + 4 * n);
#pragma unroll
        for (int ai = 0; ai < 2; ++ai)
#pragma unroll
            for (int m = 0; m < 4; ++m) { bf16_t* rowp = O + (size_t)(row0 + ai * HALF + m * 16) * ldc + col0;
#pragma unroll
                for (int bj = 0; bj < 2; ++bj) { const f32x4 v0 = acc[ai][bj][m][0] * gv[bj][0], v1 = acc[ai][bj][m][1] * gv[bj][1];
                    u32x4 w; w.x = cvt_pk_bf16(v0[0], v0[1]); w.y = cvt_pk_bf16(v0[2], v0[3]); w.z = cvt_pk_bf16(v1[0], v1[1]); w.w = cvt_pk_bf16(v1[2], v1[3]);
                    *(u32x4*)(rowp + bj * HALF) = w; } }
    }
};

template <class Epi, class Sched, bool ALIGN_EPI = false, bool SP2 = false>
__device__ __forceinline__ void gemm_phase(PG8_LAS unsigned char* lds, const Gemm g, const Sched& S, const Epi& E) {
    const int tid = threadIdx.x, wid = __builtin_amdgcn_readfirstlane(tid >> 6), lane = tid & 63, wr = wid >> 2, wc = wid & 3, fr = lane & 15, fq = lane >> 4;
    const int K = g.K, nt = K / BK;
    unsigned voffA[2], voffB[2];
#pragma unroll
    for (int i = 0; i < 2; ++i) { int R, C; stage_rc(tid * 16 + i * 8192, R, C); const int Rb = Epi::PERM ? ((R & ~31) + perm32(R & 31)) : R;
        voffA[i] = (unsigned)(R * K + C) * 2u; voffB[i] = (unsigned)(Rb * K + C) * 2u; }
    const size_t kstep = (size_t)(BK * 2);
    const size_t hstep = (size_t)HALF * K * 2;
    const size_t tstep = 2 * hstep;
    const unsigned ldsw = (unsigned)wid * 1024u;
    const int aoff = lds_byte(wr * 64 + fr, fq * 8), boff = lds_byte(wc * 32 + fr, fq * 8);
#define PG8_SA(b, h) (((b) * 2 + (h)) * HTB)
#define PG8_SB(b, h) ((4 + (b) * 2 + (h)) * HTB)
#define PG8_STAGE(bufoff, gbase, voff) do { _Pragma("unroll") for (int _i = 0; _i < 2; ++_i) \
        __builtin_amdgcn_global_load_lds((const unsigned*)((const char*)(gbase) + (voff)[_i]), (PG8_LAS unsigned*)(lds + (bufoff) + ldsw + _i * 8192), 16, 0, 0); } while (0)
#define PG8_LDA(dst, b, h) do { _Pragma("unroll") for (int m = 0; m < 4; ++m) _Pragma("unroll") for (int k = 0; k < 2; ++k) dst[m][k] = *(const PG8_LAS bf16x8*)(lds + PG8_SA(b, h) + aoff + m * 2048 + k * 1024); } while (0)
#define PG8_LDB(dst, b, h) do { _Pragma("unroll") for (int n = 0; n < 2; ++n) _Pragma("unroll") for (int k = 0; k < 2; ++k) dst[n][k] = *(const PG8_LAS bf16x8*)(lds + PG8_SB(b, h) + boff + n * 2048 + k * 1024); } while (0)
#define PG8_MMA(ai, bj, At, Bt) do { __builtin_amdgcn_s_setprio(1); _Pragma("unroll") for (int m = 0; m < 4; ++m) _Pragma("unroll") for (int n = 0; n < 2; ++n) _Pragma("unroll") for (int k = 0; k < 2; ++k) \
        acc[ai][bj][m][n] = __builtin_amdgcn_mfma_f32_16x16x32_bf16(Bt[n][k], At[m][k], acc[ai][bj][m][n], 0, 0, 0); __builtin_amdgcn_s_setprio(0); } while (0)
#define PG8_WAIT_V(n) asm volatile("s_waitcnt vmcnt(" #n ")" ::: "memory")
#define PG8_WAIT_L(n) asm volatile("s_waitcnt lgkmcnt(" #n ")" ::: "memory")
#define PG8_BAR __builtin_amdgcn_s_barrier()
#define PG8_SCHED __builtin_amdgcn_sched_barrier(0)
    Unit cur, nxt; int ui = 0;
    if (!S.next(0, cur)) return;
    f32x4 acc[2][2][4][2];
#pragma unroll
    for (int a = 0; a < 2; ++a)
#pragma unroll
        for (int b = 0; b < 2; ++b)
#pragma unroll
            for (int m = 0; m < 4; ++m)
#pragma unroll
                for (int n = 0; n < 2; ++n) acc[a][b][m][n] = (f32x4){0.f, 0.f, 0.f, 0.f};
    bf16x8 At[4][2], B0[2][2], B1[2][2];
    const char* cA = (const char*)g.A + (size_t)cur.pm * tstep; const char* cB = (const char*)g.Bt + (size_t)cur.pn * tstep;
    S.a_ready(cur);
    if constexpr (SP2) {
        PG8_STAGE(PG8_SB(0, 0), cB, voffB); PG8_STAGE(PG8_SB(0, 1), cB + hstep, voffB); PG8_STAGE(PG8_SA(0, 0), cA, voffA); PG8_STAGE(PG8_SA(0, 1), cA + hstep, voffA);
        if (wr == 1) PG8_BAR;
        PG8_WAIT_V(2); PG8_BAR;
        PG8_STAGE(PG8_SB(1, 0), cB + kstep, voffB); PG8_STAGE(PG8_SA(1, 0), cA + kstep, voffA); PG8_STAGE(PG8_SB(1, 1), cB + hstep + kstep, voffB);
        PG8_WAIT_V(6); PG8_BAR;
    } else {
        PG8_STAGE(PG8_SB(0, 0), cB, voffB); PG8_STAGE(PG8_SA(0, 0), cA, voffA); PG8_STAGE(PG8_SB(0, 1), cB + hstep, voffB); PG8_STAGE(PG8_SA(0, 1), cA + hstep, voffA);
        if (wr == 1) PG8_BAR;
        PG8_WAIT_V(4); PG8_BAR;
        PG8_STAGE(PG8_SB(1, 0), cB + kstep, voffB); PG8_STAGE(PG8_SA(1, 0), cA + kstep, voffA); PG8_STAGE(PG8_SB(1, 1), cB + hstep + kstep, voffB);
        PG8_WAIT_V(6); PG8_BAR;
    }
    for (;;) {
        const bool has_next = S.next(ui + 1, nxt);
        const char* nA = has_next ? (const char*)g.A + (size_t)nxt.pm * tstep : cA; const char* nB = has_next ? (const char*)g.Bt + (size_t)nxt.pn * tstep : cB;
        for (int t = 0; t < nt; t += 2) {
            const bool last = (t == nt - 2);
            const char* a1 = cA + (size_t)(t + 1) * kstep;
            const char* a2 = last ? nA : cA + (size_t)(t + 2) * kstep; const char* b2 = last ? nB : cB + (size_t)(t + 2) * kstep;
            const char* a3 = a2 + kstep; const char* b3 = b2 + kstep;
            if (last && has_next) S.a_ready(nxt);
            if constexpr (SP2) {
            PG8_LDB(B0, 0, 0); PG8_LDB(B1, 0, 1); PG8_SCHED; PG8_LDA(At, 0, 0); PG8_STAGE(PG8_SA(1, 1), a1 + hstep, voffA);
            PG8_WAIT_V(8); PG8_WAIT_L(0); PG8_BAR; PG8_MMA(0, 0, At, B0); PG8_MMA(0, 1, At, B1); PG8_BAR; PG8_SCHED;
            PG8_LDA(At, 0, 1); PG8_STAGE(PG8_SB(0, 0), b2, voffB); PG8_STAGE(PG8_SB(0, 1), b2 + hstep, voffB); PG8_STAGE(PG8_SA(0, 0), a2, voffA);
            PG8_WAIT_V(8); PG8_WAIT_L(0); PG8_BAR; PG8_MMA(1, 0, At, B0); PG8_MMA(1, 1, At, B1); PG8_BAR; PG8_SCHED;
            PG8_LDB(B0, 1, 0); PG8_LDB(B1, 1, 1); PG8_SCHED; PG8_LDA(At, 1, 0); PG8_STAGE(PG8_SA(0, 1), a2 + hstep, voffA);
            PG8_WAIT_V(8); PG8_WAIT_L(0); PG8_BAR; PG8_MMA(0, 0, At, B0); PG8_MMA(0, 1, At, B1); PG8_BAR; PG8_SCHED;
            PG8_LDA(At, 1, 1); PG8_STAGE(PG8_SB(1, 0), b3, voffB); PG8_STAGE(PG8_SB(1, 1), b3 + hstep, voffB); PG8_STAGE(PG8_SA(1, 0), a3, voffA);
            PG8_WAIT_V(8); PG8_WAIT_L(0); PG8_BAR; PG8_MMA(1, 0, At, B0); PG8_MMA(1, 1, At, B1); PG8_BAR; PG8_SCHED;
            } else {
            PG8_LDB(B0, 0, 0); PG8_SCHED; PG8_LDA(At, 0, 0); PG8_STAGE(PG8_SA(1, 1), a1 + hstep, voffA);
            PG8_WAIT_L(8); PG8_BAR; PG8_WAIT_L(0); PG8_MMA(0, 0, At, B0); PG8_BAR; PG8_SCHED;
            PG8_LDB(B1, 0, 1); PG8_STAGE(PG8_SB(0, 0), b2, voffB);
            PG8_BAR; PG8_WAIT_L(0); PG8_MMA(0, 1, At, B1); PG8_BAR;
            PG8_LDA(At, 0, 1); PG8_STAGE(PG8_SA(0, 0), a2, voffA);
            PG8_BAR; PG8_WAIT_L(0); PG8_MMA(1, 0, At, B0); PG8_BAR; PG8_SCHED;
            PG8_STAGE(PG8_SB(0, 1), b2 + hstep, voffB);
            PG8_WAIT_V(6); PG8_BAR; PG8_MMA(1, 1, At, B1); PG8_BAR;
            PG8_LDB(B0, 1, 0); PG8_SCHED; PG8_LDA(At, 1, 0); PG8_STAGE(PG8_SA(0, 1), a2 + hstep, voffA);
            PG8_WAIT_L(8); PG8_BAR; PG8_WAIT_L(0); PG8_MMA(0, 0, At, B0); PG8_BAR; PG8_SCHED;
            PG8_LDB(B1, 1, 1); PG8_STAGE(PG8_SB(1, 0), b3, voffB);
            PG8_BAR; PG8_WAIT_L(0); PG8_MMA(0, 1, At, B1); PG8_BAR;
            PG8_LDA(At, 1, 1); PG8_STAGE(PG8_SA(1, 0), a3, voffA);
            PG8_BAR; PG8_WAIT_L(0); PG8_MMA(1, 0, At, B0); PG8_BAR; PG8_SCHED;
            PG8_STAGE(PG8_SB(1, 1), b3 + hstep, voffB);
            PG8_WAIT_V(6); PG8_BAR; PG8_MMA(1, 1, At, B1); PG8_BAR;
            }
        }
        if constexpr (ALIGN_EPI) { if (wr == 0) PG8_BAR; }
        if constexpr (!Epi::AFTER_DRAIN) { E(acc, cur, wr, wc, fr, fq); S.done(cur); }
        if (!has_next) break;
#pragma unroll
        for (int a = 0; a < 2; ++a)
#pragma unroll
            for (int b = 0; b < 2; ++b)
#pragma unroll
                for (int m = 0; m < 4; ++m)
#pragma unroll
                    for (int n = 0; n < 2; ++n) acc[a][b][m][n] = (f32x4){0.f, 0.f, 0.f, 0.f};
        cur = nxt; cA = nA; cB = nB; ++ui;
        if constexpr (ALIGN_EPI) { if (wr == 1) PG8_BAR; }
    }
    PG8_WAIT_V(0);
    if constexpr (!ALIGN_EPI) { if (wr == 0) PG8_BAR; }
    PG8_BAR;
    if constexpr (Epi::AFTER_DRAIN) { E.fused(acc, cur, wr, wc, fr, fq, lds, wid, lane); S.done(cur); }
#undef PG8_SA
#undef PG8_SB
#undef PG8_STAGE
#undef PG8_LDA
#undef PG8_LDB
#undef PG8_MMA
#undef PG8_WAIT_V
#undef PG8_WAIT_L
#undef PG8_BAR
#undef PG8_SCHED
}
}
#define FFT_DEV __device__ __forceinline__
typedef float cf __attribute__((ext_vector_type(2)));
#ifdef FFT_HOST
#define FFT_TIE(a, b) do {} while (0)
#define FFT_STAGE_FENCE() do {} while (0)
FFT_DEV cf cmul(cf a, cf b) { cf r; r.x = a.x * b.x - a.y * b.y; r.y = a.x * b.y + a.y * b.x; return r; }
FFT_DEV cf cmulc(cf a, cf b) { cf r; r.x = a.x * b.x + a.y * b.y; r.y = a.y * b.x - a.x * b.y; return r; }
FFT_DEV cf crot_mi(cf a) { cf r; r.x = a.y; r.y = -a.x; return r; }
FFT_DEV cf crot_pi(cf a) { cf r; r.x = -a.y; r.y = a.x; return r; }
#else
#define FFT_TIE(a, b) asm volatile("" : "+v"(a), "+v"(b))
#define FFT_STAGE_FENCE() __builtin_amdgcn_sched_barrier(0)
FFT_DEV cf cmul(cf a, cf w) { cf t, r;
    asm("v_pk_mul_f32 %0, %1, %2 op_sel:[0,0] op_sel_hi:[0,1]" : "=v"(t) : "v"(a), "v"(w));
    asm("v_pk_fma_f32 %0, %1, %2, %3 op_sel:[1,1,0] op_sel_hi:[1,0,1] neg_lo:[0,1,0] neg_hi:[0,0,0]" : "=v"(r) : "v"(a), "v"(w), "v"(t));
    return r; }
FFT_DEV cf cmulc(cf a, cf w) { cf t, r;
    asm("v_pk_mul_f32 %0, %1, %2 op_sel:[0,0] op_sel_hi:[0,1] neg_lo:[0,0] neg_hi:[0,1]" : "=v"(t) : "v"(a), "v"(w));
    asm("v_pk_fma_f32 %0, %1, %2, %3 op_sel:[1,1,0] op_sel_hi:[1,0,1]" : "=v"(r) : "v"(a), "v"(w), "v"(t));
    return r; }
FFT_DEV cf crot_mi(cf a) { cf r; const cf one = {1.0f, 1.0f};
    asm("v_pk_mul_f32 %0, %1, %2 op_sel:[1,0] op_sel_hi:[0,1] neg_lo:[0,0] neg_hi:[1,0]" : "=v"(r) : "v"(a), "v"(one)); return r; }
FFT_DEV cf crot_pi(cf a) { cf r; const cf one = {1.0f, 1.0f};
    asm("v_pk_mul_f32 %0, %1, %2 op_sel:[1,0] op_sel_hi:[0,1] neg_lo:[1,0] neg_hi:[0,0]" : "=v"(r) : "v"(a), "v"(one)); return r; }
#endif
FFT_DEV cf cadd(cf a, cf b) { return a + b; }
FFT_DEV cf csub(cf a, cf b) { return a - b; }
#define FFT_C32 {1.0f, 0.98078528040323043f, 0.92387953251128674f, 0.83146961230254524f, 0.70710678118654757f, 0.55557023301960229f, 0.38268343236508984f, 0.19509032201612833f, \
                 0.0f, -0.19509032201612833f, -0.38268343236508984f, -0.55557023301960229f, -0.70710678118654757f, -0.83146961230254524f, -0.92387953251128674f, -0.98078528040323043f, \
                 -1.0f, -0.98078528040323043f, -0.92387953251128674f, -0.83146961230254524f, -0.70710678118654757f, -0.55557023301960229f, -0.38268343236508984f, -0.19509032201612833f, \
                 0.0f, 0.19509032201612833f, 0.38268343236508984f, 0.55557023301960229f, 0.70710678118654757f, 0.83146961230254524f, 0.92387953251128674f, 0.98078528040323043f}
#define FFT_S32 {0.0f, 0.19509032201612833f, 0.38268343236508984f, 0.55557023301960229f, 0.70710678118654757f, 0.83146961230254524f, 0.92387953251128674f, 0.98078528040323043f, \
                 1.0f, 0.98078528040323043f, 0.92387953251128674f, 0.83146961230254524f, 0.70710678118654757f, 0.55557023301960229f, 0.38268343236508984f, 0.19509032201612833f, \
                 0.0f, -0.19509032201612833f, -0.38268343236508984f, -0.55557023301960229f, -0.70710678118654757f, -0.83146961230254524f, -0.92387953251128674f, -0.98078528040323043f, \
                 -1.0f, -0.98078528040323043f, -0.92387953251128674f, -0.83146961230254524f, -0.70710678118654757f, -0.55557023301960229f, -0.38268343236508984f, -0.19509032201612833f}
FFT_DEV int fphys(int i) { return (i & ~15) + ((i ^ (i >> 4)) & 15) + ((i >> 9) << 4); }
constexpr int FFT_SLOTS = 16384 + 32 * 16;

template <int G, bool UPPER_ZERO = false> FFT_DEV void fft_fwd_group(cf (&r)[1 << G]) {
    constexpr float C32[32] = FFT_C32; constexpr float S32[32] = FFT_S32;
#pragma unroll
    for (int q = G - 1; q >= 0; --q) {
#pragma unroll
        for (int j = 0; j < (1 << G); ++j) {
            if (j & (1 << q)) continue;
            const int jm = j & ((1 << q) - 1), ti = jm << (4 - q);
            const bool zp = UPPER_ZERO && q == G - 1;
            const cf a = r[j], b = zp ? a : r[j + (1 << q)];
            if (!zp) r[j] = cadd(a, b);
            const cf d = zp ? a : csub(a, b);
            cf o;
            if (ti == 0) o = d;
            else if (ti == 8) o = crot_mi(d);
            else { const cf w = {C32[ti], -S32[ti]}; o = cmul(d, w); }
            r[j + (1 << q)] = o;
        }
        FFT_STAGE_FENCE();
    }
}
template <int G, bool LOWER_ONLY = false> FFT_DEV void fft_inv_group(cf (&r)[1 << G]) {
    constexpr float C32[32] = FFT_C32; constexpr float S32[32] = FFT_S32;
#pragma unroll
    for (int q = 0; q < G; ++q) {
#pragma unroll
        for (int j = 0; j < (1 << G); ++j) {
            if (j & (1 << q)) continue;
            const int jm = j & ((1 << q) - 1), ti = jm << (4 - q);
            const cf a = r[j];
            cf b = r[j + (1 << q)];
            if (ti == 0) {}
            else if (ti == 8) b = crot_pi(b);
            else { const cf w = {C32[ti], -S32[ti]}; b = cmulc(b, w); }
            r[j] = cadd(a, b);
            if (!(LOWER_ONLY && q == G - 1)) r[j + (1 << q)] = csub(a, b);
        }
        FFT_STAGE_FENCE();
    }
}
#ifdef FFT_HOST
FFT_DEV int fft_opaque(int v) { return v; }
FFT_DEV cf fft_opaque_cf(cf v) { return v; }
#else
FFT_DEV int fft_opaque(int v) { asm volatile("" : "+v"(v)); return v; }
FFT_DEV cf fft_opaque_cf(cf v) { asm volatile("" : "+v"(v)); return v; }
#endif
FFT_DEV void fft_make_tw(int tid, cf& wA, cf& wB) {
    float s, c;
    sincosf(-6.283185307179586f * (float)tid / 16384.0f, &s, &c); wA.x = c; wA.y = s;
    sincosf(-6.283185307179586f * (float)(tid & 15) / 512.0f, &s, &c); wB.x = c; wB.y = s;
}
FFT_DEV constexpr int fft_brev5(int k) { return ((k & 1) << 4) | ((k & 2) << 2) | (k & 4) | ((k & 8) >> 2) | ((k & 16) >> 4); }
template <bool INV, bool HALF = false> FFT_DEV void fft_r32(cf (&r)[32], cf w1) {
    if (!INV) { fft_fwd_group<5, HALF>(r); FFT_TIE(w1, r[0]); }
    cf wk = w1;
#pragma unroll
    for (int k = 1; k < 32; ++k) { r[fft_brev5(k)] = INV ? cmulc(r[fft_brev5(k)], wk) : cmul(r[fft_brev5(k)], wk); if (k < 31) wk = cmul(wk, w1);
        if ((k & 3) == 3) FFT_TIE(wk, r[fft_brev5(k)]); }
    if (INV) fft_inv_group<5, HALF>(r);
}
template <bool INV, bool HALF = false> FFT_DEV void fft_passA(cf* Z, int tid_, cf wA) {
    cf r[32]; const int tid = fft_opaque(tid_); const cf w1 = fft_opaque_cf(wA);
    cf* Zp = Z + fphys(tid);
#pragma unroll
    for (int j = 0; j < ((HALF && !INV) ? 16 : 32); ++j) r[j] = Zp[528 * j];
    if (HALF && !INV) {
#pragma unroll
        for (int j = 16; j < 32; ++j) r[j] = (cf){0.f, 0.f};
    }
    fft_r32<INV, HALF>(r, w1);
#pragma unroll
    for (int j = 0; j < ((HALF && INV) ? 16 : 32); ++j) Zp[528 * j] = r[j];
}
template <bool INV> FFT_DEV void fft_passB(cf* Z, int tid_, cf wB) {
    cf r[32]; const int tid = fft_opaque(tid_); const cf w1 = fft_opaque_cf(wB);
    cf* Zp = Z + (tid >> 4) * 528; const int lo4 = tid & 15;
#pragma unroll
    for (int j = 0; j < 32; ++j) r[j] = Zp[16 * j + (lo4 ^ (j & 15))];
    fft_r32<INV>(r, w1);
#pragma unroll
    for (int j = 0; j < 32; ++j) Zp[16 * j + (lo4 ^ (j & 15))] = r[j];
}
FFT_DEV void fft_passC_fwd_store(const cf* Z, int tid_, int s, cf* kfg) {
    const int tid = fft_opaque(tid_);
    cf r[16];
    const int g = (tid >> 6) * 128 + (tid & 63) + 64 * s; const cf* Zp = Z + 16 * g + 16 * (g >> 5); const int g4 = g & 15;
#pragma unroll
    for (int j = 0; j < 16; ++j) r[j] = Zp[j ^ g4];
    fft_fwd_group<4>(r);
#pragma unroll
    for (int j = 0; j < 16; ++j) kfg[(s * 16 + j) * 512 + tid] = r[j];
}
FFT_DEV void fft_passC_mul(cf* Z, int tid_, int s, const cf* kfg) {
    const int tid = fft_opaque(tid_);
    cf r[16];
    const int g = (tid >> 6) * 128 + (tid & 63) + 64 * s; cf* Zp = Z + 16 * g + 16 * (g >> 5); const int g4 = g & 15;
#pragma unroll
    for (int j = 0; j < 16; ++j) r[j] = Zp[j ^ g4];
    fft_fwd_group<4>(r);
#pragma unroll
    for (int j = 0; j < 16; ++j) r[j] = cmul(r[j], kfg[(s * 16 + j) * 512 + tid]);
    fft_inv_group<4>(r);
#pragma unroll
    for (int j = 0; j < 16; ++j) Zp[j ^ g4] = r[j];
}
FFT_DEV void fft_passC_fwd_regs(const cf* Z, int tid_, int s, cf (&kf)[16]) {
    const int tid = fft_opaque(tid_);
    const int g = (tid >> 6) * 128 + (tid & 63) + 64 * s; const cf* Zp = Z + 16 * g + 16 * (g >> 5); const int g4 = g & 15;
#pragma unroll
    for (int j = 0; j < 16; ++j) kf[j] = Zp[j ^ g4];
    fft_fwd_group<4>(kf);
}
FFT_DEV void fft_passC_mul_regs(cf* Z, int tid_, int s, const cf (&kf)[16]) {
    const int tid = fft_opaque(tid_);
    cf r[16];
    const int g = (tid >> 6) * 128 + (tid & 63) + 64 * s; cf* Zp = Z + 16 * g + 16 * (g >> 5); const int g4 = g & 15;
#pragma unroll
    for (int j = 0; j < 16; ++j) r[j] = Zp[j ^ g4];
    fft_fwd_group<4>(r);
#pragma unroll
    for (int j = 0; j < 16; ++j) r[j] = cmul(r[j], kf[j]);
    fft_inv_group<4>(r);
#pragma unroll
    for (int j = 0; j < 16; ++j) Zp[j ^ g4] = r[j];
}
FFT_DEV float fft_bf2f(unsigned short u) { return __builtin_bit_cast(float, (unsigned)u << 16); }
FFT_DEV void fft_passA_fwd_in(cf* Z, int tid_, cf wA, const unsigned short (&in0)[16], const unsigned short (&in1)[16]) {
    cf r[32]; const int tid = fft_opaque(tid_); const cf w1 = fft_opaque_cf(wA);
    cf* Zp = Z + fphys(tid);
#pragma unroll
    for (int j = 0; j < 16; ++j) { r[j] = (cf){fft_bf2f(in0[j]), fft_bf2f(in1[j])}; r[j + 16] = (cf){0.f, 0.f}; }
    fft_r32<false, true>(r, w1);
#pragma unroll
    for (int j = 0; j < 32; ++j) Zp[528 * j] = r[j];
}
template <class PK> FFT_DEV void fft_passA_inv_out(const cf* Z, int tid_, cf wA, unsigned short* y0, unsigned short* y1, float scale, PK pk) {
    cf r[32]; const int tid = fft_opaque(tid_); const cf w1 = fft_opaque_cf(wA);
    const cf* Zp = Z + fphys(tid);
#pragma unroll
    for (int j = 0; j < 32; ++j) r[j] = Zp[528 * j];
    fft_r32<true, true>(r, w1);
#pragma unroll
    for (int j = 0; j < 16; ++j) { const unsigned w = pk(r[j].x * scale, r[j].y * scale); y0[tid + 512 * j] = (unsigned short)(w & 0xffffu); y1[tid + 512 * j] = (unsigned short)(w >> 16); }
}


#include <hip/hip_cooperative_groups.h>
namespace cg = cooperative_groups;
typedef unsigned short bf16;
typedef unsigned v4u __attribute__((ext_vector_type(4)));
typedef unsigned v2u __attribute__((ext_vector_type(2)));
typedef float f32x4 __attribute__((ext_vector_type(4)));
typedef short bf16x8 __attribute__((ext_vector_type(8)));
#define LAS __attribute__((address_space(3)))
#define GAS __attribute__((address_space(1)))
#ifndef MK_N_LAUNCHES
#define MK_N_LAUNCHES 1
#endif
constexpr int NWAVES = 8, NTHR = 512;
constexpr int D = 1024, SEQ = 8192, NTOK = 65536, NCTX = 2048, INC = 3584, FF = 4096, HYW = 512;
constexpr int NPHASE = 11;
constexpr size_t MiB = 1u << 20;
constexpr size_t WS_MXF = 0, WS_HPART = 1 * MiB, WS_ROPE = 2 * MiB, WS_WIN = 4 * MiB, WS_WOUT = 11 * MiB, WS_W1 = 13 * MiB, WS_W2 = 21 * MiB,
                 WS_HT = 32 * MiB, WS_HX = 64 * MiB, WS_T = 64 * MiB, WS_U = 196 * MiB, WS_UC = 644 * MiB, WS_VXT = 648 * MiB, WS_YT = 712 * MiB,
                 WS_S = 776 * MiB, WS_MIX = 840 * MiB, WS_HID = 196 * MiB, WS_END = 968 * MiB;
constexpr int LDS_BYTES = 147456;
constexpr size_t WS_CTL = 30 * MiB, CTL_BYTES = 16384;
constexpr size_t WS_ROWSS = 31 * MiB, WS_GM = 31 * MiB + 512 * 1024, WS_SB = 31 * MiB + 640 * 1024;
constexpr int LDS_BARST_OFF = LDS_BYTES - 64;
constexpr int FFT_SCR_OFF = FFT_SLOTS * 8;
static_assert(FFT_SCR_OFF + 1024 <= LDS_BYTES, "LDS map");

struct Params {
    const float *x, *c, *ctx, *c_ctx, *w_ada, *b_ada, *norm1_g, *w_in, *cw, *cb, *f_w1, *f_b1, *f_fr1, *f_w2, *f_b2, *f_fr2, *f_w3, *hy_bias, *decay_logit, *gn_g,
                *w_out, *norm2_g, *w_mlp1, *w_mlp2, *norm_f_g;
    float* out; unsigned char* ws; int ph_lo, ph_hi;
};

__device__ __forceinline__ unsigned f2bf(float f) { unsigned u = __builtin_bit_cast(unsigned, f); return (u + 0x7fffu + ((u >> 16) & 1u)) >> 16; }
typedef float f32x2_t __attribute__((ext_vector_type(2)));
typedef __bf16 bf16x2_t __attribute__((ext_vector_type(2)));
__device__ __forceinline__ unsigned pk2(float lo, float hi) { const f32x2_t v = {lo, hi}; const bf16x2_t r = __builtin_convertvector(v, bf16x2_t); return __builtin_bit_cast(unsigned, r); }
__device__ __forceinline__ float bflo(unsigned u) { return __builtin_bit_cast(float, u << 16); }
__device__ __forceinline__ float bfhi(unsigned u) { return __builtin_bit_cast(float, u & 0xffff0000u); }
__device__ __forceinline__ void unpack8(v4u a, float (&f)[8]) { f[0] = bflo(a.x); f[1] = bfhi(a.x); f[2] = bflo(a.y); f[3] = bfhi(a.y); f[4] = bflo(a.z); f[5] = bfhi(a.z); f[6] = bflo(a.w); f[7] = bfhi(a.w); }
__device__ __forceinline__ v4u pack8(const float (&f)[8]) { v4u o; o.x = pk2(f[0], f[1]); o.y = pk2(f[2], f[3]); o.z = pk2(f[4], f[5]); o.w = pk2(f[6], f[7]); return o; }
__device__ __forceinline__ float wave_sum(float v) {
#pragma unroll
    for (int o = 1; o < 64; o <<= 1) v += __shfl_xor(v, o);
    return v;
}
__device__ __forceinline__ float fexp2(float x) { return __builtin_amdgcn_exp2f(x); }
__device__ __forceinline__ float fsilu(float g) { return g * __builtin_amdgcn_rcpf(1.0f + __builtin_amdgcn_exp2f(-1.4426950408889634f * g)); }
__device__ __forceinline__ float log_gamma_of(float logit) { return -log1pf(expf(-logit)); }

__device__ __forceinline__ void p0_transpose_item(const float* W, int K, int N, bf16* WT, float* scr, int item, int lane) {
    const int nblk = N / 32, kb = item / nblk, nb = item % nblk, k0 = 64 * kb, n0 = 32 * nb;
    float wv[32];
#pragma unroll
    for (int i = 0; i < 32; ++i) wv[i] = W[(size_t)(k0 + 2 * i + (lane >> 5)) * N + n0 + (lane & 31)];
#pragma unroll
    for (int i = 0; i < 32; ++i) scr[(2 * i + (lane >> 5)) * 33 + (lane & 31)] = wv[i];
    __builtin_amdgcn_wave_barrier(); asm volatile("s_waitcnt lgkmcnt(0)" ::: "memory");
    const int c = lane & 7;
#pragma unroll
    for (int j = 0; j < 4; ++j) { const int n = (lane >> 3) + 8 * j; const float* s = scr + (8 * c) * 33 + n;
        v4u o; o.x = pk2(s[0 * 33], s[1 * 33]); o.y = pk2(s[2 * 33], s[3 * 33]); o.z = pk2(s[4 * 33], s[5 * 33]); o.w = pk2(s[6 * 33], s[7 * 33]);
        *(v4u*)(WT + (size_t)(n0 + n) * K + k0 + 8 * c) = o; }
    asm volatile("s_waitcnt lgkmcnt(0)" ::: "memory"); __builtin_amdgcn_wave_barrier();
}

__device__ __forceinline__ void phase0(const Params& P, unsigned char* lds, int tid, int lane, int wave) {
    const int G = gridDim.x, bid = blockIdx.x;
    float* ldsf = (float*)lds;
    float* mxf = (float*)(P.ws + WS_MXF);
    for (int it = bid; it < 256; it += G) {
        for (int i = tid; i < 9 * 1024; i += NTHR) { const int r = i >> 10, k = i & 1023; const float v = r < 8 ? P.c[r * 1024 + k] : P.c_ctx[k]; ldsf[i] = v / (1.f + expf(-v)); }
        __syncthreads();
        const int col0 = it * 24, col = tid % 24, kg = tid / 24;
        float acc[9];
#pragma unroll
        for (int r = 0; r < 9; ++r) acc[r] = 0.f;
        if (tid < 504) {
            float wv[49];
#pragma unroll
            for (int i = 0; i < 49; ++i) { const int k = kg + 21 * i; wv[i] = k < 1024 ? P.w_ada[(size_t)k * 6144 + col0 + col] : 0.f; }
#pragma unroll
            for (int i = 0; i < 49; ++i) { const int k = (kg + 21 * i) & 1023;
#pragma unroll
                for (int r = 0; r < 9; ++r) acc[r] += ldsf[r * 1024 + k] * wv[i]; }
        }
        float* red = ldsf + 9 * 1024;
        if (tid < 504) {
#pragma unroll
            for (int r = 0; r < 9; ++r) red[(kg * 9 + r) * 24 + col] = acc[r];
        }
        __syncthreads();
        if (tid < 216) { const int r = tid / 24, cc = tid % 24; float s = P.b_ada[col0 + cc];
            for (int g2 = 0; g2 < 21; ++g2) s += red[(g2 * 9 + r) * 24 + cc];
            mxf[r * 6144 + col0 + cc] = s; }
        __syncthreads();
    }
    {
        float* hT = (float*)(P.ws + WS_HT); float* hpart = (float*)(P.ws + WS_HPART);
        float* z = ldsf; float* h1 = ldsf + 32 * 33; float* h2 = h1 + 32 * 64;
        for (int it = bid; it < 256; it += G) {
            const int l0 = it * 32;
            for (int i = tid; i < 32 * 33; i += NTHR) { const int pos = i / 33, zi = i - pos * 33; const float lf = (float)(l0 + pos); float v;
                if (zi == 0) v = lf / 8191.0f;
                else { const int band = (zi - 1) & 15; const float bnd = 1e-4f + (float)band * ((15.0f - 1e-4f) / 15.0f); const float a = bnd * ((float)(6.283185307179586 / 8192.0) * lf);
                       v = zi <= 16 ? cosf(a) : -sinf(a); }
                z[i] = v; }
            __syncthreads();
            for (int i = tid; i < 2048; i += NTHR) { const int pos = i >> 6, o = i & 63; float s = P.f_b1[o];
#pragma unroll
                for (int k = 0; k < 33; ++k) s += z[pos * 33 + k] * P.f_w1[k * 64 + o];
                h1[i] = sinf(P.f_fr1[o] * s); }
            __syncthreads();
            for (int i = tid; i < 2048; i += NTHR) { const int pos = i >> 6, o = i & 63; float s = P.f_b2[o];
#pragma unroll 32
                for (int k = 0; k < 64; ++k) s += h1[pos * 64 + k] * P.f_w2[k * 64 + o];
                h2[i] = sinf(P.f_fr2[o] * s); }
            __syncthreads();
            float a0[32], a1[32];
#pragma unroll
            for (int p = 0; p < 32; ++p) { a0[p] = 0.f; a1[p] = 0.f; }
            { float wa[4], wb[4];
#pragma unroll
              for (int j = 0; j < 4; ++j) { wa[j] = P.f_w3[j * 1024 + tid]; wb[j] = P.f_w3[j * 1024 + 512 + tid]; }
#pragma unroll 1
              for (int k0 = 0; k0 < 64; k0 += 4) { float na[4], nb[4];
#pragma unroll
                for (int j = 0; j < 4; ++j) { const int kn = (k0 + 4 + j) & 63; na[j] = P.f_w3[kn * 1024 + tid]; nb[j] = P.f_w3[kn * 1024 + 512 + tid]; }
#pragma unroll
                for (int j = 0; j < 4; ++j) {
#pragma unroll
                    for (int p = 0; p < 32; ++p) { const float h = h2[p * 64 + k0 + j]; a0[p] += h * wa[j]; a1[p] += h * wb[j]; } }
#pragma unroll
                for (int j = 0; j < 4; ++j) { wa[j] = na[j]; wb[j] = nb[j]; } } }
            const float la = -3.0701134573253940f, lb = -15.350567286626970f;
            const float delta = fabsf(la + (float)tid * ((lb - la) / 511.0f));
            float asum = 0.f;
#pragma unroll
            for (int p = 0; p < 32; ++p) { const float t = (float)(l0 + p) / 8191.0f; const float dk = expf(-t * delta); a0[p] *= dk; a1[p] *= dk; asum += fabsf(a0[p]) + fabsf(a1[p]); }
#pragma unroll
            for (int p = 0; p < 32; p += 4) { *(f32x4*)(hT + (size_t)tid * SEQ + l0 + p) = (f32x4){a0[p], a0[p + 1], a0[p + 2], a0[p + 3]};
                                             *(f32x4*)(hT + (size_t)(512 + tid) * SEQ + l0 + p) = (f32x4){a1[p], a1[p + 1], a1[p + 2], a1[p + 3]}; }
            hpart[it * 512 + tid] = asum;
            __syncthreads();
        }
    }
    { float* rowss = (float*)(P.ws + WS_ROWSS); for (int i = bid * NTHR + tid; i < NTOK; i += G * NTHR) rowss[i] = 0.f; }
    {
        float* rope = (float*)(P.ws + WS_ROPE);
        for (int idx = bid * NTHR + tid; idx < SEQ * 32; idx += G * NTHR) { const int l = idx >> 5, i = idx & 31; const float pos = (float)(i < 16 ? (l >> 6) : (l & 63));
            const float inv = powf(10000.0f, -(float)(i & 15) / 16.0f); float s, c; sincosf(pos * inv, &s, &c); rope[2 * idx] = c; rope[2 * idx + 1] = s; }
    }
    {
        float* scr = (float*)(lds + wave * 16384);
        const int gw = bid * NWAVES + wave, NGW = G * NWAVES;
        constexpr int I_IN = (D / 64) * (INC / 32), I_O = (D / 64) * (D / 32), I_1 = (D / 64) * (FF / 32), I_2 = (FF / 64) * (D / 32);
        for (int it = gw; it < I_IN + I_O + I_1 + I_2; it += NGW) {
            int r = it;
            if (r < I_IN) { p0_transpose_item(P.w_in, D, INC, (bf16*)(P.ws + WS_WIN), scr, r, lane); continue; } r -= I_IN;
            if (r < I_O) { p0_transpose_item(P.w_out, D, D, (bf16*)(P.ws + WS_WOUT), scr, r, lane); continue; } r -= I_O;
            if (r < I_1) { p0_transpose_item(P.w_mlp1, D, FF, (bf16*)(P.ws + WS_W1), scr, r, lane); continue; } r -= I_1;
            p0_transpose_item(P.w_mlp2, FF, D, (bf16*)(P.ws + WS_W2), scr, r, lane);
        }
    }
}

__device__ __forceinline__ void ln_mod_row2(const float* xa, const float* xb, const float* g, const float* ma, const float* mb, int sh_off, bf16* oa, bf16* ob, int lane) {
    const f32x4* pa = (const f32x4*)xa + lane; const f32x4* pb = (const f32x4*)xb + lane;
    f32x4 va[4], vb[4]; float sa = 0.f, sb = 0.f;
#pragma unroll
    for (int j = 0; j < 4; ++j) { va[j] = __builtin_nontemporal_load(pa + 64 * j); vb[j] = __builtin_nontemporal_load(pb + 64 * j); }
#pragma unroll
    for (int j = 0; j < 4; ++j) { sa += (va[j].x * va[j].x + va[j].y * va[j].y) + (va[j].z * va[j].z + va[j].w * va[j].w); sb += (vb[j].x * vb[j].x + vb[j].y * vb[j].y) + (vb[j].z * vb[j].z + vb[j].w * vb[j].w); }
    const float ra = 1.0f / sqrtf(wave_sum(sa) * (1.0f / D) + 1e-6f), rb = 1.0f / sqrtf(wave_sum(sb) * (1.0f / D) + 1e-6f);
    v2u* qa = (v2u*)oa + lane; v2u* qb = (v2u*)ob + lane;
#pragma unroll
    for (int j = 0; j < 4; ++j) { const int col = 4 * lane + 256 * j;
        const f32x4 gg = *(const f32x4*)(g + col);
        const f32x4 ya = va[j] * ra * gg * (*(const f32x4*)(ma + sh_off + 1024 + col) + 1.0f) + *(const f32x4*)(ma + sh_off + col);
        const f32x4 yb = vb[j] * rb * gg * (*(const f32x4*)(mb + sh_off + 1024 + col) + 1.0f) + *(const f32x4*)(mb + sh_off + col);
        v2u w; w.x = pk2(ya.x, ya.y); w.y = pk2(ya.z, ya.w); qa[64 * j] = w; w.x = pk2(yb.x, yb.y); w.y = pk2(yb.z, yb.w); qb[64 * j] = w; }
}
__device__ __forceinline__ void final_norm_row2(float* xa, float* xb, const float* g, int lane) {
    f32x4* pa = (f32x4*)xa + lane; f32x4* pb = (f32x4*)xb + lane;
    f32x4 va[4], vb[4]; float sa = 0.f, sb = 0.f;
#pragma unroll
    for (int j = 0; j < 4; ++j) { va[j] = pa[64 * j]; vb[j] = pb[64 * j]; }
#pragma unroll
    for (int j = 0; j < 4; ++j) { sa += (va[j].x * va[j].x + va[j].y * va[j].y) + (va[j].z * va[j].z + va[j].w * va[j].w); sb += (vb[j].x * vb[j].x + vb[j].y * vb[j].y) + (vb[j].z * vb[j].z + vb[j].w * vb[j].w); }
    const float ra = 1.0f / sqrtf(wave_sum(sa) * (1.0f / D) + 1e-6f), rb = 1.0f / sqrtf(wave_sum(sb) * (1.0f / D) + 1e-6f);
#pragma unroll
    for (int j = 0; j < 4; ++j) { const f32x4 gg = *(const f32x4*)(g + 4 * lane + 256 * j); pa[64 * j] = va[j] * ra * gg; pb[64 * j] = vb[j] * rb * gg; }
}

__device__ __forceinline__ void final_norm_row4(float* x0, const bf16* d0, const float* g, int lane) {
    f32x4 v[4][4]; v2u dl[4][4]; float s[4];
#pragma unroll
    for (int q = 0; q < 4; ++q)
#pragma unroll
        for (int j = 0; j < 4; ++j) { v[q][j] = __builtin_nontemporal_load((const f32x4*)(x0 + (size_t)q * D) + lane + 64 * j); dl[q][j] = __builtin_nontemporal_load((const v2u*)(d0 + (size_t)q * D) + lane + 64 * j); }
#pragma unroll
    for (int q = 0; q < 4; ++q) { s[q] = 0.f;
#pragma unroll
        for (int j = 0; j < 4; ++j) { v[q][j] = v[q][j] + (f32x4){bflo(dl[q][j].x), bfhi(dl[q][j].x), bflo(dl[q][j].y), bfhi(dl[q][j].y)};
            s[q] += (v[q][j].x * v[q][j].x + v[q][j].y * v[q][j].y) + (v[q][j].z * v[q][j].z + v[q][j].w * v[q][j].w); } }
#pragma unroll
    for (int o = 1; o < 64; o <<= 1) {
#pragma unroll
        for (int q = 0; q < 4; ++q) s[q] += __shfl_xor(s[q], o); }
#pragma unroll
    for (int j = 0; j < 4; ++j) { const f32x4 gg = *(const f32x4*)(g + 4 * lane + 256 * j);
#pragma unroll
        for (int q = 0; q < 4; ++q) { const float r = 1.0f / sqrtf(s[q] * (1.0f / D) + 1e-6f); __builtin_nontemporal_store(v[q][j] * r * gg, (f32x4*)(x0 + (size_t)q * D) + lane + 64 * j); } }
}

constexpr int HYW_OFF = 40960;
__device__ __forceinline__ void hy_stage_w(const Params& P, float* wl, int offA, int offB, int tid) {
    for (int i = tid; i < 8 * 512; i += NTHR) { const int r = i >> 9, c = i & 511; float v;
        if (r < 3) v = P.cw[r * 1536 + offA + c]; else if (r < 6) v = P.cw[(r - 3) * 1536 + offB + c]; else if (r == 6) v = P.cb[offA + c]; else v = P.cb[offB + c];
        wl[i] = v; }
}
struct HPreRegs { v4u dx[2][3], dv[2][3]; };
__device__ __forceinline__ void hpre_issue(HPreRegs& R, int it_, const bf16* U, int tid) {
    const int it = 4095 - it_;
    const int tl = tid >> 3, c8 = tid & 7;
    const int tt = it >> 2, cb = (it & 3) * 128, tok0 = tt * 64, l = (tok0 & (SEQ - 1)) + tl;
#pragma unroll
    for (int s = 0; s < 2; ++s)
#pragma unroll
        for (int r = 0; r < 3; ++r) { const int lr = l + r - 1; const bool ok = lr >= 0 && lr < SEQ;
            const bf16* up = U + (size_t)(tok0 + tl + (ok ? r - 1 : 0)) * INC + cb + s * 64 + c8 * 8;
            R.dx[s][r] = *(const v4u*)(up + 512); R.dv[s][r] = *(const v4u*)(up + 1024);
            if (!ok) { R.dx[s][r] = (v4u){0u, 0u, 0u, 0u}; R.dv[s][r] = (v4u){0u, 0u, 0u, 0u}; } }
}
__device__ __forceinline__ void hy_pre(const Params& P, unsigned char* lds, int tid) {
    const bf16* U = (const bf16*)(P.ws + WS_U); bf16* VXT = (bf16*)(P.ws + WS_VXT);
    bf16* T = (bf16*)lds;
    float* wl = (float*)(lds + HYW_OFF);
    hy_stage_w(P, wl, 512, 1024, tid);
    HPreRegs R;
    if ((int)blockIdx.x < 4096) hpre_issue(R, blockIdx.x, U, tid);
    __syncthreads();
    const int tl = tid >> 3, c8 = tid & 7;
    for (int it_ = blockIdx.x; it_ < 4096; it_ += gridDim.x) {
        const int it = 4095 - it_;
        const int tt = it >> 2, cb = (it & 3) * 128, tok0 = tt * 64, b = tok0 >> 13, l0 = tok0 & (SEQ - 1);
#pragma unroll
        for (int s = 0; s < 2; ++s) { const int cc = cb + s * 64 + c8 * 8;
            float ax[8], av[8];
            { const f32x4 a0 = *(const f32x4*)(wl + 6 * 512 + cc), a1 = *(const f32x4*)(wl + 6 * 512 + cc + 4), b0 = *(const f32x4*)(wl + 7 * 512 + cc), b1 = *(const f32x4*)(wl + 7 * 512 + cc + 4);
              ax[0] = a0.x; ax[1] = a0.y; ax[2] = a0.z; ax[3] = a0.w; ax[4] = a1.x; ax[5] = a1.y; ax[6] = a1.z; ax[7] = a1.w;
              av[0] = b0.x; av[1] = b0.y; av[2] = b0.z; av[3] = b0.w; av[4] = b1.x; av[5] = b1.y; av[6] = b1.z; av[7] = b1.w; }
#pragma unroll
            for (int r = 0; r < 3; ++r) { float fx[8], fv[8]; unpack8(R.dx[s][r], fx); unpack8(R.dv[s][r], fv);
                const f32x4 wa0 = *(const f32x4*)(wl + r * 512 + cc), wa1 = *(const f32x4*)(wl + r * 512 + cc + 4), wb0 = *(const f32x4*)(wl + (3 + r) * 512 + cc), wb1 = *(const f32x4*)(wl + (3 + r) * 512 + cc + 4);
                ax[0] += fx[0] * wa0.x; ax[1] += fx[1] * wa0.y; ax[2] += fx[2] * wa0.z; ax[3] += fx[3] * wa0.w; ax[4] += fx[4] * wa1.x; ax[5] += fx[5] * wa1.y; ax[6] += fx[6] * wa1.z; ax[7] += fx[7] * wa1.w;
                av[0] += fv[0] * wb0.x; av[1] += fv[1] * wb0.y; av[2] += fv[2] * wb0.z; av[3] += fv[3] * wb0.w; av[4] += fv[4] * wb1.x; av[5] += fv[5] * wb1.y; av[6] += fv[6] * wb1.z; av[7] += fv[7] * wb1.w; }
#pragma unroll
            for (int e = 0; e < 8; ++e) T[(s * 64 + c8 * 8 + e) * 72 + (tl ^ (c8 << 3))] = (bf16)f2bf(ax[e] * av[e]);
        }
        __syncthreads();
        if (it_ + (int)gridDim.x < 4096) hpre_issue(R, it_ + gridDim.x, U, tid);
#pragma unroll
        for (int q = 0; q < 2; ++q) { const int ch = q * 64 + (tid >> 3), t8 = tid & 7;
            *(v4u*)(VXT + ((size_t)(b * HYW + cb + ch)) * SEQ + l0 + t8 * 8) = *(const v4u*)(T + ch * 72 + ((t8 ^ ((ch >> 3) & 7)) << 3)); }
        __syncthreads();
    }
}
struct HPostRegs { v4u yv[4]; v4u dx[4][3]; };
__device__ __forceinline__ void hp_issue(HPostRegs& R, int it, const bf16* U, const bf16* YT, int tid) {
    const int tl = tid >> 3, c8 = tid & 7;
    const int tt = it >> 1, cb = (it & 1) * 256, tok0 = tt * 64, b = tok0 >> 13, l0 = tok0 & (SEQ - 1), l = l0 + tl;
#pragma unroll
    for (int q = 0; q < 4; ++q) { const int ch = q * 64 + (tid >> 3), t8 = tid & 7; R.yv[q] = *(const v4u*)(YT + ((size_t)(b * HYW + cb + ch)) * SEQ + l0 + t8 * 8); }
#pragma unroll
    for (int s = 0; s < 4; ++s)
#pragma unroll
        for (int r = 0; r < 3; ++r) { const int lr = l + r - 1; const bool ok = lr >= 0 && lr < SEQ;
            R.dx[s][r] = *(const v4u*)(U + (size_t)(tok0 + tl + (ok ? r - 1 : 0)) * INC + cb + s * 64 + c8 * 8);
            if (!ok) R.dx[s][r] = (v4u){0u, 0u, 0u, 0u}; }
}
__device__ __forceinline__ void hy_post(const Params& P, unsigned char* lds, int tid) {
    const bf16* U = (const bf16*)(P.ws + WS_U); const bf16* YT = (const bf16*)(P.ws + WS_YT); bf16* MIX = (bf16*)(P.ws + WS_MIX);
    bf16* T = (bf16*)lds;
    float* wl = (float*)(lds + HYW_OFF);
    hy_stage_w(P, wl, 0, 0, tid);
    HPostRegs R;
    if ((int)blockIdx.x < 2048) hp_issue(R, blockIdx.x, U, YT, tid);
    __syncthreads();
    const int tl = tid >> 3, c8 = tid & 7;
    for (int it = blockIdx.x; it < 2048; it += gridDim.x) {
        const int tt = it >> 1, cb = (it & 1) * 256, tok0 = tt * 64;
#pragma unroll
        for (int q = 0; q < 4; ++q) { const int ch = q * 64 + (tid >> 3), t8 = tid & 7; const v4u a = R.yv[q];
            T[(t8 * 8 + 0) * 264 + (ch ^ (t8 << 3))] = (bf16)(a.x & 0xffffu); T[(t8 * 8 + 1) * 264 + (ch ^ (t8 << 3))] = (bf16)(a.x >> 16);
            T[(t8 * 8 + 2) * 264 + (ch ^ (t8 << 3))] = (bf16)(a.y & 0xffffu); T[(t8 * 8 + 3) * 264 + (ch ^ (t8 << 3))] = (bf16)(a.y >> 16);
            T[(t8 * 8 + 4) * 264 + (ch ^ (t8 << 3))] = (bf16)(a.z & 0xffffu); T[(t8 * 8 + 5) * 264 + (ch ^ (t8 << 3))] = (bf16)(a.z >> 16);
            T[(t8 * 8 + 6) * 264 + (ch ^ (t8 << 3))] = (bf16)(a.w & 0xffffu); T[(t8 * 8 + 7) * 264 + (ch ^ (t8 << 3))] = (bf16)(a.w >> 16); }
        v4u dxc[4][3];
#pragma unroll
        for (int s = 0; s < 4; ++s)
#pragma unroll
            for (int r = 0; r < 3; ++r) dxc[s][r] = R.dx[s][r];
        __syncthreads();
        if (it + (int)gridDim.x < 2048) hp_issue(R, it + gridDim.x, U, YT, tid);
#pragma unroll
        for (int s = 0; s < 4; ++s) { const int cc = cb + s * 64 + c8 * 8;
            float ax[8], y[8];
            { const f32x4 a0 = *(const f32x4*)(wl + 6 * 512 + cc), a1 = *(const f32x4*)(wl + 6 * 512 + cc + 4);
              ax[0] = a0.x; ax[1] = a0.y; ax[2] = a0.z; ax[3] = a0.w; ax[4] = a1.x; ax[5] = a1.y; ax[6] = a1.z; ax[7] = a1.w; }
#pragma unroll
            for (int r = 0; r < 3; ++r) { float fx[8]; unpack8(dxc[s][r], fx);
                const f32x4 wa0 = *(const f32x4*)(wl + r * 512 + cc), wa1 = *(const f32x4*)(wl + r * 512 + cc + 4);
                ax[0] += fx[0] * wa0.x; ax[1] += fx[1] * wa0.y; ax[2] += fx[2] * wa0.z; ax[3] += fx[3] * wa0.w; ax[4] += fx[4] * wa1.x; ax[5] += fx[5] * wa1.y; ax[6] += fx[6] * wa1.z; ax[7] += fx[7] * wa1.w; }
            unpack8(*(const v4u*)(T + tl * 264 + s * 64 + ((c8 ^ (tl >> 3)) << 3)), y);
#pragma unroll
            for (int e = 0; e < 8; ++e) y[e] *= ax[e];
            *(v4u*)(MIX + (size_t)(tok0 + tl) * D + cc) = pack8(y);
        }
        __syncthreads();
    }
}

#define WAVE_LDS_FENCE() do { asm volatile("s_waitcnt lgkmcnt(0)" ::: "memory"); __builtin_amdgcn_wave_barrier(); } while (0)
__device__ __forceinline__ void hy_fft(const Params& P, unsigned char* lds, int tid, int lane, int wave) {
    cf* Z = (cf*)lds; float* scr = (float*)(lds + FFT_SCR_OFF);
    const float* hT = (const float*)(P.ws + WS_HT); const float* hpart = (const float*)(P.ws + WS_HPART);
    const unsigned short* VXT = (const unsigned short*)(P.ws + WS_VXT); unsigned short* YT = (unsigned short*)(P.ws + WS_YT);
    cf twA, twB; fft_make_tw(tid, twA, twB);
    for (int c = blockIdx.x; c < HYW; c += gridDim.x) {
        unsigned short in0[16], in1[16];
        { const unsigned short* v0 = VXT + ((size_t)(0 * HYW + c)) * SEQ + fft_opaque(tid); const unsigned short* v1 = v0 + (size_t)HYW * SEQ;
#pragma unroll
          for (int j = 0; j < 16; ++j) { in0[j] = v0[512 * j]; in1[j] = v1[512 * j]; } }
        float fv[32]; const int t_ = fft_opaque(tid);
#pragma unroll
        for (int j = 0; j < 16; ++j) fv[j] = hT[(size_t)c * SEQ + t_ + 512 * j];
#pragma unroll
        for (int j = 16; j < 32; ++j) { const int i = t_ + 512 * j; fv[j] = i == SEQ ? 0.f : hT[(size_t)(512 + c) * SEQ + (16384 - i)]; }
        const float bias = P.hy_bias[c];
        float p = tid < 256 ? hpart[tid * 512 + c] : 0.f; p = wave_sum(p);
        __syncthreads();
        if (lane == 0) scr[wave] = p;
        __syncthreads();
        float nrm = 1e-6f;
#pragma unroll
        for (int w = 0; w < NWAVES; ++w) nrm += scr[w];
        const float inv = 1.0f / nrm;
        {
#pragma unroll
          for (int j = 0; j < 32; ++j) { const int i = t_ + 512 * j; float v = fv[j] * inv; if (i == 0) v += bias; cf e; e.x = v; e.y = 0.f; Z[fphys(t_) + 528 * j] = e; } }
        __syncthreads(); fft_passA<false>(Z, tid, twA);
        __syncthreads(); fft_passB<false>(Z, tid, twB);
        WAVE_LDS_FENCE();
        cf kf0[16], kf1[16];
        fft_passC_fwd_regs(Z, tid, 0, kf0); fft_passC_fwd_regs(Z, tid, 1, kf1);
        for (int bp = 0; bp < 4; ++bp) {
            __syncthreads();
            fft_passA_fwd_in(Z, tid, twA, in0, in1);
            __syncthreads();
            fft_passB<false>(Z, tid, twB); WAVE_LDS_FENCE();
            fft_passC_mul_regs(Z, tid, 0, kf0); fft_passC_mul_regs(Z, tid, 1, kf1); WAVE_LDS_FENCE();
            fft_passB<true>(Z, tid, twB);
            if (bp < 3) { const unsigned short* v0 = VXT + ((size_t)((2 * bp + 2) * HYW + c)) * SEQ + fft_opaque(tid); const unsigned short* v1 = v0 + (size_t)HYW * SEQ;
#pragma unroll
                for (int j = 0; j < 16; ++j) { in0[j] = v0[512 * j]; in1[j] = v1[512 * j]; } }
            __syncthreads();
            unsigned short* y0 = YT + ((size_t)((2 * bp) * HYW + c)) * SEQ; unsigned short* y1 = y0 + (size_t)HYW * SEQ;
            fft_passA_inv_out(Z, tid, twA, y0, y1, 1.0f / 16384.0f, [](float a, float b_) { return pk2(a, b_); });
        }
    }
}

__device__ __forceinline__ bf16x8 lds_frag(const bf16* base, int stride, int row0, int k0, int lane) {
    return *(const bf16x8*)(base + (row0 + (lane & 15)) * stride + k0 + (lane >> 4) * 8);
}
__device__ __forceinline__ bf16x8 lds_frag_sw(const bf16* base, int row0, int k0, int lane) {
    return *(const bf16x8*)(base + (row0 + (lane & 15)) * 136 + ((k0 + (lane >> 4) * 8) ^ row0));
}
#define MFMA16(x, y, acc) __builtin_amdgcn_mfma_f32_16x16x32_bf16((x), (y), (acc), 0, 0, 0)
struct R1Regs { v4u k0, k1, v0, v1; f32x4 rp[4]; };
__device__ __forceinline__ void r1_issue(R1Regs& R, int it, const bf16* U, const bf16* UC, const float* rope, int m, int dq) {
    const int itr = 64 * 66 - 1 - it;
    const int bh = itr / 66, n = itr - bh * 66, b = bh >> 3, h = bh & 7;
    const bf16 *kp, *vp;
    if (n < 64) { const size_t row = (size_t)b * SEQ + n * 128 + m; kp = U + row * INC + 2048 + h * 64 + dq * 16; vp = kp + 512;
        const f32x4* rl = (const f32x4*)(rope + (size_t)(n * 128 + m) * 64 + dq * 16);
#pragma unroll
        for (int q = 0; q < 4; ++q) R.rp[q] = rl[q]; }
    else { const size_t row = (size_t)b * 256 + (n - 64) * 128 + m; kp = UC + row * 1024 + h * 64 + dq * 16; vp = kp + 512;
#pragma unroll
        for (int q = 0; q < 4; ++q) R.rp[q] = (f32x4){1.f, 0.f, 1.f, 0.f}; }
    R.k0 = *(const v4u*)kp; R.k1 = *(const v4u*)(kp + 8); R.v0 = *(const v4u*)vp; R.v1 = *(const v4u*)(vp + 8);
}
__device__ __forceinline__ void rope16(v4u a, v4u b, const f32x4 (&rp)[4], float scale, float (&f)[16]) {
    float x[8], y[8]; unpack8(a, x); unpack8(b, y);
#pragma unroll
    for (int e = 0; e < 8; ++e) { f[e] = x[e]; f[8 + e] = y[e]; }
#pragma unroll
    for (int q = 0; q < 4; ++q) { const f32x4 cs = rp[q];
        const float a0 = f[4 * q], b0 = f[4 * q + 1], a1 = f[4 * q + 2], b1 = f[4 * q + 3];
        f[4 * q] = (a0 * cs.x - b0 * cs.y) * scale; f[4 * q + 1] = (a0 * cs.y + b0 * cs.x) * scale; f[4 * q + 2] = (a1 * cs.z - b1 * cs.w) * scale; f[4 * q + 3] = (a1 * cs.w + b1 * cs.z) * scale; }
}
__device__ __forceinline__ void ret_r1(const Params& P, unsigned char* lds, int tid, int lane, int wave) {
    const bf16* U = (const bf16*)(P.ws + WS_U); const bf16* UC = (const bf16*)(P.ws + WS_UC); const float* rope = (const float*)(P.ws + WS_ROPE);
    bf16* T = (bf16*)(P.ws + WS_T);
    bf16* Kf = (bf16*)lds; bf16* Kb = Kf + 64 * 136; bf16* Vt = Kb + 64 * 136;
    const int m = tid >> 2, dq = tid & 3;
    R1Regs R;
    if ((int)blockIdx.x < 64 * 66) r1_issue(R, blockIdx.x, U, UC, rope, m, dq);
    float* lgt = (float*)(lds + 3 * 64 * 136 * 2);
    if (tid < 16) lgt[tid] = log_gamma_of(P.decay_logit[tid]) * 1.4426950408889634f;
    __syncthreads();
    for (int it = blockIdx.x; it < 64 * 66; it += gridDim.x) {
        const int itr = 64 * 66 - 1 - it;
        const int bh = itr / 66, n = itr - bh * 66, h = bh & 7;
        const float lgf2 = lgt[h], lgb2 = lgt[8 + h];
        const int msw = m ^ (dq << 4);
        float kk[16]; rope16(R.k0, R.k1, R.rp, 0.125f, kk);
        const float wf = fexp2(lgf2 * (float)(127 - m)), wb = fexp2(lgb2 * (float)m);
#pragma unroll
        for (int e = 0; e < 16; e += 2) { const unsigned pf_ = pk2(kk[e] * wf, kk[e + 1] * wf), pb_ = pk2(kk[e] * wb, kk[e + 1] * wb);
            Kf[(dq * 16 + e) * 136 + msw] = (bf16)(pf_ & 0xffffu); Kf[(dq * 16 + e + 1) * 136 + msw] = (bf16)(pf_ >> 16);
            Kb[(dq * 16 + e) * 136 + msw] = (bf16)(pb_ & 0xffffu); Kb[(dq * 16 + e + 1) * 136 + msw] = (bf16)(pb_ >> 16); }
        const unsigned vv[8] = {R.v0.x, R.v0.y, R.v0.z, R.v0.w, R.v1.x, R.v1.y, R.v1.z, R.v1.w};
#pragma unroll
        for (int e = 0; e < 8; ++e) { Vt[(dq * 16 + 2 * e) * 136 + msw] = (bf16)(vv[e] & 0xffffu); Vt[(dq * 16 + 2 * e + 1) * 136 + msw] = (bf16)(vv[e] >> 16); }
        __syncthreads();
        if (it + (int)gridDim.x < 64 * 66) r1_issue(R, it + gridDim.x, U, UC, rope, m, dq);
        const int dir = wave >> 2, et = wave & 3;
        const bf16* Kw = dir ? Kb : Kf;
        bf16x8 yf[4];
#pragma unroll
        for (int kc = 0; kc < 4; ++kc) yf[kc] = lds_frag_sw(Vt, et * 16, kc * 32, lane);
        bf16* Tout = T + ((size_t)(bh * 66 + n) * 2 + dir) * 4096;
#pragma unroll
        for (int dt = 0; dt < 4; ++dt) { f32x4 acc = {0.f, 0.f, 0.f, 0.f};
#pragma unroll
            for (int kc = 0; kc < 4; ++kc) acc = MFMA16(lds_frag_sw(Kw, dt * 16, kc * 32, lane), yf[kc], acc);
            v2u tw; tw.x = pk2(acc[0], acc[1]); tw.y = pk2(acc[2], acc[3]); *(v2u*)(Tout + (et * 16 + (lane & 15)) * 64 + dt * 16 + (lane >> 4) * 4) = tw; }
        __syncthreads();
    }
}
__device__ __forceinline__ f32x4 ld4bf(const bf16* p) { const v2u w = *(const v2u*)p; return (f32x4){bflo(w.x), bfhi(w.x), bflo(w.y), bfhi(w.y)}; }
__device__ __forceinline__ void ret_r2(const Params& P, int tid) {
    const bf16* T = (const bf16*)(P.ws + WS_T); bf16* S = (bf16*)(P.ws + WS_S);
    for (int idx = blockIdx.x * NTHR + tid; idx < 64 * 2 * 1024; idx += gridDim.x * NTHR) {
        const int bh = idx >> 11, dir = (idx >> 10) & 1, el = (idx & 1023) * 4, h = bh & 7;
        const float dec = expf(log_gamma_of(P.decay_logit[dir * 8 + h]) * 128.0f);
        const bf16* Tb = T + (size_t)bh * 66 * 8192 + dir * 4096 + el;
        bf16* Sb = S + (size_t)bh * 64 * 8192 + dir * 4096 + el;
        const f32x4 c0 = ld4bf(Tb + 64 * 8192), c1 = ld4bf(Tb + 65 * 8192);
        f32x4 s = dir == 0 ? c0 * dec + c1 : c0 + c1 * dec;
        if (dir == 0) {
            for (int n0 = 0; n0 < 64; n0 += 16) { v2u t[16];
#pragma unroll
                for (int u = 0; u < 16; ++u) t[u] = *(const v2u*)(Tb + (size_t)(n0 + u) * 8192);
#pragma unroll
                for (int u = 0; u < 16; ++u) { v2u w; w.x = pk2(s.x, s.y); w.y = pk2(s.z, s.w); *(v2u*)(Sb + (size_t)(n0 + u) * 8192) = w;
                    s = s * dec + (f32x4){bflo(t[u].x), bfhi(t[u].x), bflo(t[u].y), bfhi(t[u].y)}; } }
        } else {
            for (int n0 = 48; n0 >= 0; n0 -= 16) { v2u t[16];
#pragma unroll
                for (int u = 0; u < 16; ++u) t[u] = *(const v2u*)(Tb + (size_t)(n0 + u) * 8192);
#pragma unroll
                for (int u = 15; u >= 0; --u) { v2u w; w.x = pk2(s.x, s.y); w.y = pk2(s.z, s.w); *(v2u*)(Sb + (size_t)(n0 + u) * 8192) = w;
                    s = s * dec + (f32x4){bflo(t[u].x), bfhi(t[u].x), bflo(t[u].y), bfhi(t[u].y)}; } }
        }
    }
}
struct R3Regs { v4u q0, q1, k0, k1, v0, v1, sf, sb; f32x4 rp[4]; v2u g[4]; };
__device__ __forceinline__ void r3_issue(R3Regs& R, int it, const bf16* U, const bf16* S, const float* rope, const float* gn_g, int tid, int lane, int wave) {
    const int bh = it >> 6, n = it & 63, b = bh >> 3, h = bh & 7, m = tid >> 2, dq = tid & 3;
    const size_t rowbase = (size_t)b * SEQ + n * 128;
    const bf16* up = U + (rowbase + m) * INC + h * 64 + dq * 16;
    const f32x4* rl = (const f32x4*)(rope + (size_t)(n * 128 + m) * 64 + dq * 16);
    R.q0 = *(const v4u*)(up + 1536); R.q1 = *(const v4u*)(up + 1544); R.k0 = *(const v4u*)(up + 2048); R.k1 = *(const v4u*)(up + 2056); R.v0 = *(const v4u*)(up + 2560); R.v1 = *(const v4u*)(up + 2568);
#pragma unroll
    for (int q = 0; q < 4; ++q) R.rp[q] = rl[q];
    const bf16* sp = S + ((size_t)(bh * 64 + n) * 2) * 4096 + tid * 8;
    R.sf = *(const v4u*)sp; R.sb = *(const v4u*)(sp + 4096);
    const bf16* gp = U + (rowbase + wave * 16 + (lane & 15)) * INC + 3072 + h * 64 + (lane >> 4) * 4;
#pragma unroll
    for (int et = 0; et < 4; ++et) R.g[et] = *(const v2u*)(gp + et * 16);
}
__device__ __forceinline__ void ret_r3(const Params& P, unsigned char* lds, int tid, int lane, int wave) {
    const bf16* U = (const bf16*)(P.ws + WS_U); const float* rope = (const float*)(P.ws + WS_ROPE); const bf16* S = (const bf16*)(P.ws + WS_S);
    bf16* MIX = (bf16*)(P.ws + WS_MIX);
    bf16* Qs = (bf16*)lds; bf16* Ks = Qs + 128 * 72; bf16* Vt = Ks + 128 * 72; bf16* Ps = Vt + 64 * 136; bf16* Sfs = Ps + 128 * 136; bf16* Sbs = Sfs + 64 * 72;
    const int m = tid >> 2, dq = tid & 3;
    R3Regs R;
    if ((int)blockIdx.x < 64 * 64) r3_issue(R, blockIdx.x, U, S, rope, P.gn_g, tid, lane, wave);
    float* lgt = (float*)(lds + 110592);
    float* gnl = lgt + 16;
    if (tid < 16) lgt[tid] = log_gamma_of(P.decay_logit[tid]) * 1.4426950408889634f;
    gnl[tid] = P.gn_g[tid];
    __syncthreads();
    for (int it = blockIdx.x; it < 64 * 64; it += gridDim.x) {
        const int bh = it >> 6, n = it & 63, b = bh >> 3, h = bh & 7;
        const float lgf2 = lgt[h], lgb2 = lgt[8 + h];
        const size_t rowbase = (size_t)b * SEQ + n * 128;
        {
            float q[16], kk[16]; rope16(R.q0, R.q1, R.rp, 1.0f, q); rope16(R.k0, R.k1, R.rp, 0.125f, kk);
            { float t0[8], t1[8];
#pragma unroll
              for (int e = 0; e < 8; ++e) { t0[e] = q[e]; t1[e] = q[8 + e]; }
              *(v4u*)(Qs + m * 72 + dq * 16) = pack8(t0); *(v4u*)(Qs + m * 72 + dq * 16 + 8) = pack8(t1);
#pragma unroll
              for (int e = 0; e < 8; ++e) { t0[e] = kk[e]; t1[e] = kk[8 + e]; }
              *(v4u*)(Ks + m * 72 + dq * 16) = pack8(t0); *(v4u*)(Ks + m * 72 + dq * 16 + 8) = pack8(t1); }
            const unsigned vv[8] = {R.v0.x, R.v0.y, R.v0.z, R.v0.w, R.v1.x, R.v1.y, R.v1.z, R.v1.w};
            const int msw = m ^ (dq << 4);
#pragma unroll
            for (int e = 0; e < 8; ++e) { Vt[(dq * 16 + 2 * e) * 136 + msw] = (bf16)(vv[e] & 0xffffu); Vt[(dq * 16 + 2 * e + 1) * 136 + msw] = (bf16)(vv[e] >> 16); }
            const int se = (tid * 8) >> 6, sd = (tid * 8) & 63;
            *(v4u*)(Sfs + se * 72 + sd) = R.sf; *(v4u*)(Sbs + se * 72 + sd) = R.sb;
        }
        v2u gcur[4];
#pragma unroll
        for (int et = 0; et < 4; ++et) gcur[et] = R.g[et];
        __syncthreads();
        if (it + (int)gridDim.x < 64 * 64) r3_issue(R, it + gridDim.x, U, S, rope, P.gn_g, tid, lane, wave);
        const int cl = wave * 16 + (lane & 15);
        bf16x8 yq[2];
        yq[0] = lds_frag(Qs, 72, wave * 16, 0, lane); yq[1] = lds_frag(Qs, 72, wave * 16, 32, lane);
#pragma unroll
        for (int mt = 0; mt < 8; ++mt) { f32x4 acc = {0.f, 0.f, 0.f, 0.f};
            acc = MFMA16(lds_frag(Ks, 72, mt * 16, 0, lane), yq[0], acc); acc = MFMA16(lds_frag(Ks, 72, mt * 16, 32, lane), yq[1], acc);
            const int m0 = mt * 16 + (lane >> 4) * 4; float pv[4];
#pragma unroll
            for (int j = 0; j < 4; ++j) { const int diff = cl - (m0 + j); const float dv = diff > 0 ? fexp2(lgf2 * (float)diff) : (diff < 0 ? fexp2(lgb2 * (float)(-diff)) : 2.0f); pv[j] = acc[j] * dv; }
            v2u w; w.x = pk2(pv[0], pv[1]); w.y = pk2(pv[2], pv[3]); *(v2u*)(Ps + cl * 136 + m0) = w; }
        WAVE_LDS_FENCE();
        f32x4 ao[4], af[4], ab[4];
#pragma unroll
        for (int et = 0; et < 4; ++et) { ao[et] = (f32x4){0.f, 0.f, 0.f, 0.f}; af[et] = ao[et]; ab[et] = ao[et]; }
#pragma unroll
        for (int kc = 0; kc < 4; ++kc) { const bf16x8 yp = lds_frag(Ps, 136, wave * 16, kc * 32, lane);
#pragma unroll
            for (int et = 0; et < 4; ++et) ao[et] = MFMA16(lds_frag_sw(Vt, et * 16, kc * 32, lane), yp, ao[et]); }
#pragma unroll
        for (int kc = 0; kc < 2; ++kc)
#pragma unroll
            for (int et = 0; et < 4; ++et) { af[et] = MFMA16(lds_frag(Sfs, 72, et * 16, kc * 32, lane), yq[kc], af[et]); ab[et] = MFMA16(lds_frag(Sbs, 72, et * 16, kc * 32, lane), yq[kc], ab[et]); }
        const float wqf = fexp2(lgf2 * (float)(cl + 1)), wqb = fexp2(lgb2 * (float)(128 - cl));
        float s1 = 0.f;
#pragma unroll
        for (int et = 0; et < 4; ++et) { ao[et] = ao[et] + af[et] * wqf + ab[et] * wqb; s1 += (ao[et].x + ao[et].y) + (ao[et].z + ao[et].w); }
        s1 += __shfl_xor(s1, 16); s1 += __shfl_xor(s1, 32);
        const float mu = s1 * (1.0f / 64.0f); float s2 = 0.f;
#pragma unroll
        for (int et = 0; et < 4; ++et) { ao[et] = ao[et] - mu; s2 += (ao[et].x * ao[et].x + ao[et].y * ao[et].y) + (ao[et].z * ao[et].z + ao[et].w * ao[et].w); }
        s2 += __shfl_xor(s2, 16); s2 += __shfl_xor(s2, 32);
        const float rstd = 1.0f / sqrtf(s2 * (1.0f / 64.0f) + 1e-6f);
        bf16* op = MIX + (rowbase + cl) * D + 512 + h * 64;
#pragma unroll
        for (int et = 0; et < 4; ++et) { const int e0 = et * 16 + (lane >> 4) * 4;
            const v2u gw = gcur[et]; const f32x4 gn = *(const f32x4*)(gnl + h * 64 + e0);
            const float o0 = ao[et].x * rstd * gn.x * fsilu(bflo(gw.x)), o1 = ao[et].y * rstd * gn.y * fsilu(bfhi(gw.x));
            const float o2 = ao[et].z * rstd * gn.z * fsilu(bflo(gw.y)), o3 = ao[et].w * rstd * gn.w * fsilu(bfhi(gw.y));
            v2u w; w.x = pk2(o0, o1); w.y = pk2(o2, o3); *(v2u*)(op + e0) = w; }
        __syncthreads();
    }
}

#define XB_TMO      128
#define XB_XCNT(j)  (256  + 64 * (j))
#define XB_XSUB(j)  (1280 + 64 * (j))
#define XB_XGEN(j)  (2304 + 64 * (j))
#define XB_TOP      3328
#define XB_TOPGEN   3392
#define XCD_BAR_WORDS 3456
#define XB_SPIN_CAP (1u << 18)

__device__ __forceinline__ unsigned xb_ld(unsigned* p)              { return __hip_atomic_load(p, __ATOMIC_RELAXED, __HIP_MEMORY_SCOPE_AGENT); }
__device__ __forceinline__ unsigned xb_add(unsigned* p, unsigned v) { return __hip_atomic_fetch_add(p, v, __ATOMIC_RELAXED, __HIP_MEMORY_SCOPE_AGENT); }
__device__ __forceinline__ unsigned xb_xcc_id() { return (unsigned)__builtin_amdgcn_s_getreg((3 << 11) | 20) & 0xFu; }
#define XB_SPIN(cond, bar) do { unsigned _sp = 0; while (cond) { __builtin_amdgcn_s_sleep(1); \
    if ((++_sp & 255u) == 0u) { if (xb_ld(&(bar)[XB_TMO])) break; if (_sp > XB_SPIN_CAP) { atomicAdd(&(bar)[XB_TMO], 1u); break; } } } } while (0)

struct XcdBarrier {
    unsigned* bar; unsigned x;
    volatile LAS unsigned* st;
};

__device__ __forceinline__ XcdBarrier xcd_barrier_post(unsigned* bar, volatile LAS unsigned* st) {
    XcdBarrier b; b.bar = bar; b.x = xb_xcc_id(); b.st = st;
    if (threadIdx.x == 0) (void)xb_add(&bar[XB_XCNT(b.x)], 1u);
    return b;
}
__device__ __forceinline__ void xcd_barrier_complete(unsigned* bar, unsigned x, unsigned& nloc, unsigned& nx) {
    const unsigned G = gridDim.x * gridDim.y * gridDim.z;
    unsigned sum, cnt, mine, sp = 0u;
    for (;;) {
        sum = 0u; cnt = 0u; mine = 0u;
#pragma unroll
        for (unsigned j = 0; j < 16; ++j) { const unsigned c = xb_ld(&bar[XB_XCNT(j)]); sum += c; cnt += (c > 0u) ? 1u : 0u; mine = (j == x) ? c : mine; }
        if (sum == G) break;
        __builtin_amdgcn_s_sleep(1);
        if ((++sp & 255u) == 0u) { if (xb_ld(&bar[XB_TMO])) break; if (sp > XB_SPIN_CAP) { atomicAdd(&bar[XB_TMO], 1u); break; } }
    }
    nloc = mine > 0u ? mine : 1u; nx = cnt > 0u ? cnt : 1u;
}

__device__ __forceinline__ void xcd_barrier(const XcdBarrier& b) {
    asm volatile("s_waitcnt vmcnt(0)" ::: "memory");
    __syncthreads();
    if (threadIdx.x == 0) {
        unsigned* bar = b.bar;
        __builtin_amdgcn_s_waitcnt(0);
        unsigned nloc = b.st[0], nx = b.st[1];
        if (nloc == 0u) { xcd_barrier_complete(bar, b.x, nloc, nx); b.st[0] = nloc; b.st[1] = nx; }
        const unsigned old = xb_add(&bar[XB_XSUB(b.x)], 1u);
        const unsigned gen = old / nloc;
        if (old + 1u == (gen + 1u) * nloc) {
            __builtin_amdgcn_fence(__ATOMIC_RELEASE, "agent");
            asm volatile("s_waitcnt vmcnt(0)" ::: "memory");
            const unsigned og = xb_add(&bar[XB_TOP], 1u);
            const unsigned tg = og / nx;
            if (og + 1u == (tg + 1u) * nx) xb_add(&bar[XB_TOPGEN], 1u);
            else XB_SPIN(xb_ld(&bar[XB_TOPGEN]) == tg, bar);
            __builtin_amdgcn_fence(__ATOMIC_ACQUIRE, "agent");
            xb_add(&bar[XB_XGEN(b.x)], 1u);
            asm volatile("s_waitcnt vmcnt(0)" ::: "memory");
        } else {
            XB_SPIN(xb_ld(&bar[XB_XGEN(b.x)]) == gen, bar);
            __builtin_amdgcn_fence(__ATOMIC_ACQUIRE, "agent");
            asm volatile("s_waitcnt vmcnt(0)" ::: "memory");
        }
    }
    __syncthreads();
}

__global__ void __launch_bounds__(NTHR, 2) hymba_fwd(Params P) {
    extern __shared__ __attribute__((aligned(16))) unsigned char lds[];
    const int tid = threadIdx.x, lane = tid & 63, wave = __builtin_amdgcn_readfirstlane(tid >> 6);
    const int G = gridDim.x, bid = blockIdx.x;
    const int lo = P.ph_lo, hi = P.ph_hi;
    unsigned char* ws = P.ws;
    const float* mxf = (const float*)(ws + WS_MXF);
#ifndef REP_MASK
#define REP_MASK 0
#endif
#ifndef EXTRA_SYNCS
#define EXTRA_SYNCS 0
#endif
#ifndef PH_MASK
#define PH_MASK 0x7ff
#endif
#define IN(k) (((PH_MASK >> (k)) & 1) && lo <= (k) && (k) < hi)
    if (tid < 16) ((volatile LAS unsigned*)((LAS unsigned char*)lds + LDS_BARST_OFF))[tid] = 0u;
    __syncthreads();
    const XcdBarrier bar = xcd_barrier_post((unsigned*)(ws + WS_CTL), (volatile LAS unsigned*)((LAS unsigned char*)lds + LDS_BARST_OFF));
    if (lo < 0) cg::this_grid().sync();
#define SEAM(k) do { if (IN(k) && IN((k) + 1)) xcd_barrier(bar); } while (0)
    const int gw = bid * NWAVES + wave, NGW = G * NWAVES;
    if (IN(0)) { phase0(P, lds, tid, lane, wave); if ((REP_MASK >> 0) & 1) { __syncthreads(); phase0(P, lds, tid, lane, wave); } }
    SEAM(0);
    constexpr int NCB = (NCTX / 256) * (1024 / 256);
    const bool ctx_in_p1 = G >= 2 * NCB;
    if (IN(1)) {
        bf16* HX = (bf16*)(ws + WS_HX);
        const float* m8 = mxf + (size_t)8 * 6144;
        if (ctx_in_p1 && bid < NCB) {
            pg8::StaticOrder S; S.init(NCTX, 1024, NCB, bid); pg8::Unit u0; S.next(0, u0);
            for (int i = 0; i < 32; i += 2) { const int r = u0.pm * 256 + wave * 32 + i;
                ln_mod_row2(P.ctx + (size_t)r * D, P.ctx + (size_t)(r + 1) * D, P.norm1_g, m8, m8, 0, HX + (size_t)(NTOK + r) * D, HX + (size_t)(NTOK + r + 1) * D, lane); }
            asm volatile("s_waitcnt vmcnt(0)" ::: "memory"); __syncthreads();
            pg8::Gemm g{(const pg8::bf16_t*)(ws + WS_HX) + (size_t)NTOK * D, (const pg8::bf16_t*)(ws + WS_WIN) + (size_t)2048 * D, NCTX, 1024, D};
            pg8::EpiBf16<0> E{(pg8::bf16_t*)(ws + WS_UC), 1024, nullptr, 0, 0, 1.f, nullptr, 0};
            pg8::gemm_phase<pg8::EpiBf16<0>, pg8::StaticOrder, true, true>((LAS unsigned char*)lds, g, S, E);
            __syncthreads();
        } else {
            const int wgw = (ctx_in_p1 ? bid - NCB : bid) * NWAVES + wave, WNGW = (ctx_in_p1 ? G - NCB : G) * NWAVES, nrows = ctx_in_p1 ? NTOK : NTOK + NCTX;
            for (int r = 2 * wgw; r < nrows; r += 2 * WNGW) {
                const float* xa = r < NTOK ? P.x + (size_t)r * D : P.ctx + (size_t)(r - NTOK) * D;
                const float* m_ = mxf + (size_t)(r < NTOK ? (r >> 13) : 8) * 6144;
                ln_mod_row2(xa, xa + D, P.norm1_g, m_, m_, 0, HX + (size_t)r * D, HX + (size_t)(r + 1) * D, lane);
            }
        }
    }
    if (IN(1)) {
        float* gm = (float*)(ws + WS_GM); float* sbt = (float*)(ws + WS_SB); const bf16* W1T = (const bf16*)(ws + WS_W1);
        for (int i = bid * NTHR + tid; i < 8 * 1024; i += G * NTHR) { const int b_ = i >> 10, c_ = i & 1023; gm[i] = P.norm2_g[c_] * (1.0f + mxf[(size_t)b_ * 6144 + 4 * 1024 + c_]); }
        for (int n = gw; n < FF; n += NGW) {
            float w[16]; { float t0[8], t1[8]; unpack8(*(const v4u*)(W1T + (size_t)n * D + lane * 16), t0); unpack8(*(const v4u*)(W1T + (size_t)n * D + lane * 16 + 8), t1);
#pragma unroll
                for (int e = 0; e < 8; ++e) { w[e] = t0[e]; w[8 + e] = t1[e]; } }
#pragma unroll
            for (int b_ = 0; b_ < 8; ++b_) { const float* sh = mxf + (size_t)b_ * 6144 + 3 * 1024 + lane * 16; float s = 0.f;
#pragma unroll
                for (int q = 0; q < 4; ++q) { const f32x4 v = *(const f32x4*)(sh + 4 * q); s += (v.x * w[4 * q] + v.y * w[4 * q + 1]) + (v.z * w[4 * q + 2] + v.w * w[4 * q + 3]); }
                s = wave_sum(s); if (lane == 0) sbt[b_ * FF + n] = s; }
        }
    }
    SEAM(1);
    if (IN(2)) {
        { pg8::Gemm g{(const pg8::bf16_t*)(ws + WS_HX), (const pg8::bf16_t*)(ws + WS_WIN), NTOK, INC, D}; pg8::StaticOrder S; S.init(NTOK, INC, G, bid);
          pg8::EpiBf16<0> E{(pg8::bf16_t*)(ws + WS_U), INC, nullptr, 0, 0, 1.f, nullptr, 0};
          pg8::gemm_phase<pg8::EpiBf16<0>, pg8::StaticOrder, true, true>((LAS unsigned char*)lds, g, S, E); }
        __syncthreads();
        if (!ctx_in_p1) { pg8::Gemm g{(const pg8::bf16_t*)(ws + WS_HX) + (size_t)NTOK * D, (const pg8::bf16_t*)(ws + WS_WIN) + (size_t)2048 * D, NCTX, 1024, D}; pg8::StaticOrder S; S.init(NCTX, 1024, G, bid);
          pg8::EpiBf16<0> E{(pg8::bf16_t*)(ws + WS_UC), 1024, nullptr, 0, 0, 1.f, nullptr, 0};
          pg8::gemm_phase<pg8::EpiBf16<0>, pg8::StaticOrder, true, true>((LAS unsigned char*)lds, g, S, E); }
        __syncthreads();
    }
    SEAM(2);
    for (int rep = 0; rep < 1 + ((REP_MASK >> 3) & 1); ++rep)
    if (IN(3)) {
        if (bid & 1) { ret_r1(P, lds, tid, lane, wave); __syncthreads(); hy_pre(P, lds, tid); } else { hy_pre(P, lds, tid); ret_r1(P, lds, tid, lane, wave); }
    }
    SEAM(3);
    for (int rep = 0; rep < 1 + ((REP_MASK >> 4) & 1); ++rep)
    if (IN(4)) { hy_fft(P, lds, tid, lane, wave); if ((REP_MASK >> 11) & 1) hy_fft(P, lds, tid, lane, wave); ret_r2(P, tid); if ((REP_MASK >> 12) & 1) ret_r2(P, tid); }
    SEAM(4);
    for (int rep = 0; rep < 1 + ((REP_MASK >> 5) & 1); ++rep)
    if (IN(5)) {
        hy_post(P, lds, tid); ret_r3(P, lds, tid, lane, wave);
    }
    SEAM(5);
    if (IN(6)) {
        pg8::Gemm g{(const pg8::bf16_t*)(ws + WS_MIX), (const pg8::bf16_t*)(ws + WS_WOUT), NTOK, D, D}; pg8::StaticOrder S; S.init(NTOK, D, G, bid);
        pg8::EpiResF32Ln E{P.x, P.out, mxf + 2 * 1024, D, (const float*)(ws + WS_GM), (pg8::bf16_t*)(ws + WS_HX), (float*)(ws + WS_ROWSS)};
        pg8::gemm_phase<pg8::EpiResF32Ln, pg8::StaticOrder, true, true>((LAS unsigned char*)lds, g, S, E);
        __syncthreads();
    }
    if (IN(6) && IN(8)) xcd_barrier(bar);
    if (IN(8)) {
        pg8::Gemm g{(const pg8::bf16_t*)(ws + WS_HX), (const pg8::bf16_t*)(ws + WS_W1), NTOK, FF, D}; pg8::StaticOrder S; S.init(NTOK, FF, G, bid);
        pg8::EpiBf16<2> E{(pg8::bf16_t*)(ws + WS_HID), FF, (const float*)(ws + WS_SB), 0, 0, 1.f, (const float*)(ws + WS_ROWSS), FF};
        pg8::gemm_phase<pg8::EpiBf16<2>, pg8::StaticOrder, true, true>((LAS unsigned char*)lds, g, S, E);
        __syncthreads();
    }
    SEAM(8);
    if (IN(9)) {
        pg8::Gemm g{(const pg8::bf16_t*)(ws + WS_HID), (const pg8::bf16_t*)(ws + WS_W2), NTOK, D, FF}; pg8::RevStaticOrder S; S.init(NTOK, D, G, bid);
        pg8::EpiGateBf16 E{(pg8::bf16_t*)(ws + WS_MIX), D, mxf + 5 * 1024};
        pg8::gemm_phase<pg8::EpiGateBf16, pg8::RevStaticOrder, true, true>((LAS unsigned char*)lds, g, S, E);
        __syncthreads();
    }
    SEAM(9);
    for (int es = 0; es < EXTRA_SYNCS; ++es) xcd_barrier(bar);
    if (IN(10)) { for (int r = 4 * gw; r < NTOK; r += 4 * NGW) final_norm_row4(P.out + (size_t)r * D, (const bf16*)(ws + WS_MIX) + (size_t)r * D, P.norm_f_g, lane); }
#undef IN
#undef SEAM
}

extern "C" void kernel_launch(void* const* d_in, const int* in_sizes, int n_in, void* d_out, int out_size, void* d_ws, size_t ws_size, hipStream_t stream) {
    static int grid = 0;
    if (grid == 0) {
        if (n_in != 25 || in_sizes[0] != NTOK * D || out_size != NTOK * D || ws_size < WS_END) { fprintf(stderr, "kernel_launch: unexpected shapes (n_in %d, in0 %d, out %d, ws %zu; need ws >= %zu)\n", n_in, n_in > 0 ? in_sizes[0] : -1, out_size, ws_size, (size_t)WS_END); grid = -1; return; }
        int dev = 0, cus = 0, per_cu = 0;
        if (hipGetDevice(&dev) != hipSuccess || hipDeviceGetAttribute(&cus, hipDeviceAttributeMultiprocessorCount, dev) != hipSuccess) { grid = -1; return; }
        if (hipFuncSetAttribute((const void*)hymba_fwd, hipFuncAttributeMaxDynamicSharedMemorySize, LDS_BYTES) != hipSuccess) { fprintf(stderr, "kernel_launch: hipFuncSetAttribute failed\n"); grid = -1; return; }
        if (hipOccupancyMaxActiveBlocksPerMultiprocessor(&per_cu, (const void*)hymba_fwd, NTHR, LDS_BYTES) != hipSuccess || per_cu < 1) { fprintf(stderr, "kernel_launch: occupancy query says %d blocks/CU\n", per_cu); (void)hipGetLastError(); grid = -1; return; }
        grid = cus * 1;
    }
    if (grid < 0) return;
    Params p{};
    const float** pp = (const float**)&p;
    for (int i = 0; i < 25; ++i) pp[i] = (const float*)d_in[i];
    p.out = (float*)d_out; p.ws = (unsigned char*)d_ws;
    p.ph_lo = 0; p.ph_hi = NPHASE;
    if (hipMemsetAsync((char*)d_ws + WS_CTL, 0, CTL_BYTES, stream) != hipSuccess) { fprintf(stderr, "kernel_launch: memset of the barrier words failed\n"); return; }
    void* args[] = {&p};
    hipError_t e = hipLaunchCooperativeKernel((const void*)hymba_fwd, dim3(grid), dim3(NTHR), args, LDS_BYTES, stream);
    if (e != hipSuccess) fprintf(stderr, "cooperative launch failed: %s (grid %d)\n", hipGetErrorString(e), grid);
}
```
